# Optimizing an MI355X kernel written in HIP

```python
import math
import numpy as np
import jax
import jax.numpy as jnp
from jax import lax

D_MODEL = 2048
BATCH = 8
SEQ = 2048
DEPTH = 1

CHUNK = 64
Q_BLOCK = 128
HA = 8
DA_QK = 64
DA_V = 2 * DA_QK
QK_A = HA * 2 * DA_QK
WIDTH_A = HA * DA_V
HB = 8
DB = 128
WIDTH_B = HB * DB
LEFT_CHUNKS = 8
BAND = (LEFT_CHUNKS + 1) * CHUNK
REL_CLIP = 256
T5_BUCKETS = 32
T5_MAX_DIST = 128
IN_SPLITS = [QK_A, 2 * QK_A, 2 * QK_A + WIDTH_A,
             2 * QK_A + WIDTH_A + WIDTH_B,
             2 * QK_A + WIDTH_A + 2 * WIDTH_B,
             2 * QK_A + WIDTH_A + 3 * WIDTH_B]
IN_COLS = 2 * QK_A + WIDTH_A + 3 * WIDTH_B + 2 * D_MODEL
N_EXPERTS = 64
TOP_K = 8
N_GROUPS = 8
TOPK_GROUPS = 4
D_EXPERT = 512
D_SHARED = 512
ROUTED_SCALE = 2.5
MOE_BLOCK = 128
N_MOD = 6
EPS = 1e-6
HEAD_EPS = 1e-5
NEG = -1e30

kernel_name = "hybrid_chunk_causal_diffattn_bandattn_moe"


def rmsnorm(x, g):
    xf = x.astype(jnp.float32)
    y = xf * lax.rsqrt(jnp.mean(xf * xf, axis=-1, keepdims=True) + EPS)
    return (y * g.astype(jnp.float32)).astype(x.dtype)


def head_rmsnorm(x):
    xf = x.astype(jnp.float32)
    return (xf * lax.rsqrt(jnp.mean(xf * xf, axis=-1, keepdims=True) + HEAD_EPS)).astype(x.dtype)


def t5_bucket(rel):
    nb = T5_BUCKETS // 2
    ret = (rel > 0).astype(np.int32) * nb
    n = np.abs(rel)
    max_exact = nb // 2
    large = max_exact + (np.log(np.maximum(n, 1) / max_exact) / math.log(T5_MAX_DIST / max_exact)
                         * (nb - max_exact)).astype(np.int32)
    large = np.minimum(large, nb - 1)
    return (ret + np.where(n < max_exact, n, large)).astype(np.int32)


def diff_attention(q, k, v, lam, lam_init, t5_table):
    b_, s_ = q.shape[0], q.shape[1]
    scale = DA_QK ** -0.5
    outs = []
    for start in range(0, s_, Q_BLOCK):
        end = start + Q_BLOCK
        qpos = np.arange(start, end)
        kpos = np.arange(end)
        allowed = (kpos[None, :] // CHUNK) <= (qpos[:, None] // CHUNK)
        bias = jnp.transpose(t5_table[t5_bucket(kpos[None, :] - qpos[:, None])], (2, 0, 1))
        s = jnp.einsum('bqhmd,bkhmd->bhmqk', q[:, start:end], k[:, :end]).astype(jnp.float32) * scale
        s = jnp.where(allowed, s + bias.astype(jnp.float32)[None, :, None], NEG)
        p = jax.nn.softmax(s, axis=-1)
        a = p[:, :, 0] - lam * p[:, :, 1]
        outs.append(jnp.einsum('bhqk,bkhe->bqhe', a.astype(v.dtype), v[:, :end]))
    o = jnp.concatenate(outs, axis=1)
    o = head_rmsnorm(o) * (1.0 - lam_init)
    return o.reshape(b_, s_, WIDTH_A)


def chunk_band_attention(q, k, v, rel_table):
    b_, s_ = q.shape[0], q.shape[1]
    nc = s_ // CHUNK
    qc = q.reshape(b_, nc, CHUNK, HB, DB)
    pad = ((0, 0), (LEFT_CHUNKS * CHUNK, 0), (0, 0), (0, 0))
    kp = jnp.pad(k, pad).reshape(b_, nc + LEFT_CHUNKS, CHUNK, HB, DB)
    vp = jnp.pad(v, pad).reshape(b_, nc + LEFT_CHUNKS, CHUNK, HB, DB)
    idx = np.arange(nc)[:, None] + np.arange(LEFT_CHUNKS + 1)[None, :]
    kb = kp[:, idx].reshape(b_, nc, BAND, HB, DB)
    vb = vp[:, idx].reshape(b_, nc, BAND, HB, DB)
    s = jnp.einsum('bnqhd,bnkhd->bhnqk', qc, kb).astype(jnp.float32) * (DB ** -0.5)
    qq = np.arange(CHUNK)
    kk = np.arange(BAND) - LEFT_CHUNKS * CHUNK
    rel = np.clip(kk[None, :] - qq[:, None], -REL_CLIP, REL_CLIP) + REL_CLIP
    bias = jnp.transpose(rel_table[rel], (2, 0, 1)).astype(jnp.float32)
    valid = (np.arange(nc)[:, None] * CHUNK + kk[None, :]) >= 0
    s = jnp.where(valid[None, None, :, None, :], s + bias[None, :, None], NEG)
    p = jax.nn.softmax(s, axis=-1)
    o = jnp.einsum('bhnqk,bnkhd->bnqhd', p.astype(v.dtype), vb)
    return o.reshape(b_, s_, WIDTH_B)


def moe_ffn(u, w_router, router_bias, wg, wu, wd, sg, su, sd):
    t_ = u.shape[0]
    scores = jax.nn.sigmoid(jnp.dot(u, w_router).astype(jnp.float32))
    biased = scores + router_bias.astype(jnp.float32)
    grp = biased.reshape(t_, N_GROUPS, N_EXPERTS // N_GROUPS)
    grp_score = lax.top_k(grp, 2)[0].sum(-1)
    _, gidx = lax.top_k(grp_score, TOPK_GROUPS)
    gmask = jax.nn.one_hot(gidx, N_GROUPS, dtype=jnp.float32).sum(1) > 0
    emask = jnp.repeat(gmask, N_EXPERTS // N_GROUPS, axis=1)
    _, eidx = lax.top_k(jnp.where(emask, biased, -jnp.inf), TOP_K)
    w = jnp.take_along_axis(scores, eidx, axis=1)
    w = w / jnp.sum(w, axis=-1, keepdims=True) * ROUTED_SCALE
    a_ = t_ * TOP_K
    nb = -(-(a_ + N_EXPERTS * (MOE_BLOCK - 1)) // MOE_BLOCK)
    p_ = nb * MOE_BLOCK
    flat_e = eidx.reshape(a_)
    flat_tok = jnp.repeat(jnp.arange(t_, dtype=jnp.int32), TOP_K)
    flat_w = w.reshape(a_).astype(u.dtype)
    order = jnp.argsort(flat_e)
    se = flat_e[order]
    counts = jnp.bincount(flat_e, length=N_EXPERTS)
    starts = jnp.cumsum(counts) - counts
    pcounts = (counts + MOE_BLOCK - 1) // MOE_BLOCK * MOE_BLOCK
    pends = jnp.cumsum(pcounts)
    pstarts = pends - pcounts
    dest = pstarts[se] + jnp.arange(a_, dtype=jnp.int32) - starts[se]
    slot_tok = jnp.zeros((p_,), jnp.int32).at[dest].set(flat_tok[order])
    slot_w = jnp.zeros((p_,), u.dtype).at[dest].set(flat_w[order])
    block_e = jnp.minimum(jnp.searchsorted(pends, jnp.arange(nb) * MOE_BLOCK, side='right'),
                          N_EXPERTS - 1)

    def expert_block(args):
        tok, e = args
        xb = u[tok]
        hb = jax.nn.silu(xb @ wg[e]) * (xb @ wu[e])
        return hb @ wd[e]

    out = lax.map(expert_block, (slot_tok.reshape(nb, MOE_BLOCK), block_e))
    routed = jax.ops.segment_sum(out.reshape(p_, -1) * slot_w[:, None], slot_tok, num_segments=t_)
    shared = (jax.nn.silu(u @ sg) * (u @ su)) @ sd
    return routed + shared


def setup_inputs(seed: int = 0) -> dict:
    key = jax.random.key(seed)
    ks = jax.random.split(key, 24)
    f32 = jnp.float32
    D = D_MODEL

    def nrm(k, shape, scale):
        return jax.random.normal(k, shape, f32) * scale

    return {
        "x": nrm(ks[0], (BATCH, SEQ, D), 1.0),
        "c": nrm(ks[1], (BATCH, D), 1.0),
        "w_ada": nrm(ks[2], (DEPTH, D, N_MOD * D), 0.5 * D ** -0.5),
        "b_ada": nrm(ks[3], (DEPTH, N_MOD * D), 0.02),
        "g_attn": 1.0 + nrm(ks[4], (DEPTH, D), 0.02),
        "w_in": nrm(ks[5], (DEPTH, D, IN_COLS), D ** -0.5),
        "lambda_qk": nrm(ks[6], (DEPTH, 4, DA_QK), 0.1),
        "t5_bias": nrm(ks[7], (T5_BUCKETS, HA), 0.5),
        "rel_bias_b": nrm(ks[8], (DEPTH, 2 * REL_CLIP + 1, HB), 0.5),
        "w_up_a": nrm(ks[9], (DEPTH, WIDTH_A, D), WIDTH_A ** -0.5),
        "w_up_b": nrm(ks[10], (DEPTH, WIDTH_B, D), WIDTH_B ** -0.5),
        "w_o": nrm(ks[11], (DEPTH, D, D), D ** -0.5),
        "g_moe": 1.0 + nrm(ks[12], (DEPTH, D), 0.02),
        "w_router": nrm(ks[13], (DEPTH, D, N_EXPERTS), D ** -0.5),
        "router_bias": nrm(ks[14], (DEPTH, N_EXPERTS), 0.01),
        "w_exp_gate": nrm(ks[15], (DEPTH, N_EXPERTS, D, D_EXPERT), D ** -0.5),
        "w_exp_up": nrm(ks[16], (DEPTH, N_EXPERTS, D, D_EXPERT), D ** -0.5),
        "w_exp_down": nrm(ks[17], (DEPTH, N_EXPERTS, D_EXPERT, D), D_EXPERT ** -0.5),
        "w_sh_gate": nrm(ks[18], (DEPTH, D, D_SHARED), D ** -0.5),
        "w_sh_up": nrm(ks[19], (DEPTH, D, D_SHARED), D ** -0.5),
        "w_sh_down": nrm(ks[20], (DEPTH, D_SHARED, D), D_SHARED ** -0.5),
        "g_final": 1.0 + nrm(ks[21], (D,), 0.02),
    }


def reference(x, c, w_ada, b_ada, g_attn, w_in, lambda_qk, t5_bias, rel_bias_b, w_up_a, w_up_b, w_o,
              g_moe, w_router, router_bias, w_exp_gate, w_exp_up, w_exp_down,
              w_sh_gate, w_sh_up, w_sh_down, g_final):
    b_, s_, d_ = x.shape
    h = x
    for l in range(DEPTH):
        mod = jnp.dot(jax.nn.silu(c), w_ada[l]) + b_ada[l]
        sh_a, sc_a, gt_a, sh_m, sc_m, gt_m = jnp.split(mod[:, None, :], N_MOD, axis=-1)

        u = rmsnorm(h, g_attn[l]) * (1.0 + sc_a) + sh_a
        proj = u @ w_in[l]
        qa, ka, va, qb, kb, vb, gates = jnp.split(proj, IN_SPLITS, axis=-1)
        lam_init = 0.8 - 0.6 * math.exp(-0.3 * l)
        lq = lambda_qk[l].astype(jnp.float32)
        lam = jnp.exp(jnp.sum(lq[0] * lq[1])) - jnp.exp(jnp.sum(lq[2] * lq[3])) + lam_init
        ya = diff_attention(qa.reshape(b_, s_, HA, 2, DA_QK), ka.reshape(b_, s_, HA, 2, DA_QK),
                            va.reshape(b_, s_, HA, DA_V), lam, lam_init, t5_bias)
        yb = chunk_band_attention(qb.reshape(b_, s_, HB, DB), kb.reshape(b_, s_, HB, DB),
                                  vb.reshape(b_, s_, HB, DB), rel_bias_b[l])
        g_a, g_b = jnp.split(jax.nn.sigmoid(gates), 2, axis=-1)
        merged = g_a * (ya @ w_up_a[l]) + g_b * (yb @ w_up_b[l])
        h = h + gt_a * (merged @ w_o[l])

        v = rmsnorm(h, g_moe[l]) * (1.0 + sc_m) + sh_m
        y = moe_ffn(v.reshape(b_ * s_, d_), w_router[l], router_bias[l], w_exp_gate[l], w_exp_up[l],
                    w_exp_down[l], w_sh_gate[l], w_sh_up[l], w_sh_down[l])
        h = h + gt_m * y.reshape(b_, s_, d_)
    return rmsnorm(h, g_final)
```

```cpp
#include <hip/hip_runtime.h>
#include <cstdio>
#include <cstdint>

#ifndef MK_N_LAUNCHES
#define MK_N_LAUNCHES 1
#endif

#define LAS __attribute__((address_space(3)))
#define GAS __attribute__((address_space(1)))
typedef unsigned short bf16_t;
typedef short bf16x8 __attribute__((ext_vector_type(8)));
typedef short s16x4 __attribute__((ext_vector_type(4)));
typedef float f32x2 __attribute__((ext_vector_type(2)));
typedef float f32x4 __attribute__((ext_vector_type(4)));
typedef float f32x16 __attribute__((ext_vector_type(16)));
typedef unsigned u32x2 __attribute__((ext_vector_type(2)));
typedef unsigned u32x4 __attribute__((ext_vector_type(4)));

constexpr int NB = 8, SEQ = 2048, DM = 2048, T = NB * SEQ;
constexpr int NPROJ = 10240;
constexpr int C_QA = 0, C_KA = 1024, C_VA = 2048, C_QB = 3072, C_KB = 4096, C_VB = 5120, C_GA = 6144, C_GB = 8192;
constexpr int NE = 64, NEX = 65  , DE = 512, ECAP = 16384;
constexpr int NMOD = 6 * DM;
constexpr float LOG2E = 1.4426950408889634f;
constexpr float QA_SCALE = 0.125f * LOG2E;
constexpr float QB_SCALE = 0.08838834764831845f * LOG2E;
constexpr float LAM_INIT = 0.2f;
constexpr float WGU_SCALE = 64.0f, WD_SCALE = 32.0f, WINB_SCALE = 64.0f, WUB_SCALE = 32.0f, YB_SCALE = 8.0f, WO_SCALE = 64.0f, MG_SCALE = 8.0f, WUA_SCALE = 32.0f, YA_SCALE = 8.0f;
constexpr size_t WS_WIN_B_OFF = 0;
constexpr int MAXTILES = 640;

constexpr size_t MiB = 1u << 20;
constexpr size_t WS_CTL = 0, CTL_ZERO_BYTES = 1 * MiB;
constexpr size_t WS_MOD = 1 * MiB;
constexpr size_t WS_SELPK = 2 * MiB, WS_SELW = 2 * MiB + 512 * 1024;
constexpr size_t WS_TOK = 3 * MiB;
constexpr size_t WS_WRT = 7 * MiB;
constexpr size_t WS_WD = 8 * MiB;
constexpr size_t WS_UV = 138 * MiB;
constexpr size_t WS_HB = 202 * MiB;
constexpr size_t WS_V8 = WS_HB + 96 * MiB;
constexpr size_t WS_YA8 = WS_HB;
constexpr size_t WS_YB8 = WS_HB + 80 * MiB;
constexpr size_t WS_U8 = WS_HB + 128 * MiB;
constexpr size_t WS_M8 = WS_U8;
constexpr size_t WS_R1 = 362 * MiB;
constexpr size_t WS_PART = WS_R1;
constexpr size_t WS_WIN = WS_R1 + 12 * MiB;
constexpr size_t WS_WUA = WS_WIN + 40 * MiB, WS_WUB = WS_WUA + 4 * MiB, WS_WO = WS_WUB + 4 * MiB;
constexpr size_t WS_WGU = WS_WO + 8 * MiB;
constexpr size_t WS_PROJ = WS_WGU + 260 * MiB;
constexpr size_t WS_H1 = WS_PROJ;
constexpr size_t WS_YS = WS_R1;
constexpr size_t WS_END = WS_PROJ + 320 * MiB;
static_assert(WS_YS + (size_t)MAXTILES * 256 * 2048 <= WS_WGU + 130 * MiB + 130 * MiB, "ys overlay");
constexpr int CW_TMO = 0, CW_CODE = 1;
constexpr int CW_CNT = 1024;
constexpr int CW_BAR = 8192;

constexpr int RING_BYTES = 131072;
constexpr int MISC_OFF = 133120;
constexpr int TAB_OFF = MISC_OFF + 256;
constexpr int PF_OFF = 147456;
constexpr int LDS_BYTES = 147456 + 2048;
constexpr int NWAVES = 8;

#define LDS_WAIT() asm volatile("s_waitcnt lgkmcnt(0)" ::: "memory")
__device__ __forceinline__ unsigned asm_lane_id() { unsigned l; asm volatile("v_mbcnt_lo_u32_b32 %0, -1, 0\n\tv_mbcnt_hi_u32_b32 %0, -1, %0" : "=v"(l)); return l; }
#define VM_WAIT() asm volatile("s_waitcnt vmcnt(0)" ::: "memory")

__device__ __forceinline__ unsigned cvt_pk_bf16(float lo, float hi) { unsigned r; asm volatile("v_cvt_pk_bf16_f32 %0, %1, %2" : "=v"(r) : "v"(lo), "v"(hi)); return r; }
__device__ __forceinline__ float bf_lo(unsigned w) { return __uint_as_float(w << 16); }
__device__ __forceinline__ float bf_hi(unsigned w) { return __uint_as_float(w & 0xffff0000u); }
__device__ __forceinline__ float sigmoidf_fast(float x) { return __builtin_amdgcn_rcpf(1.0f + __builtin_amdgcn_exp2f(-LOG2E * x)); }
__device__ __forceinline__ unsigned pk4_fp8(float a, float b, float c, float d) { int w = __builtin_amdgcn_cvt_pk_fp8_f32(a, b, 0, false); w = __builtin_amdgcn_cvt_pk_fp8_f32(c, d, w, true); return (unsigned)w; }
__device__ __forceinline__ float wave_sum(float v) {
#pragma unroll
    for (int o = 1; o < 64; o <<= 1) v += __shfl_xor(v, o);
    return v;
}

namespace pg8 {
constexpr int BM = 256, BK = 64, HALF = 128, HTB = HALF * BK * 2, STAGE_BYTES = 8 * HTB, NXCD = 8, WGM = 8;
__host__ __device__ __forceinline__ int lds_byte(int r, int c) { const int st = (r >> 4) * 2 + (c >> 5), rr = r & 15, cc = c & 31, ob = rr * 64 + cc * 2; return st * 1024 + (ob ^ (((ob >> 9) & 1) << 5)); }
__host__ __device__ __forceinline__ void stage_rc(int b, int& R, int& C) { const int st = b / 1024, sb = b % 1024, swz = sb ^ (((sb >> 9) & 1) << 5); R = (st >> 1) * 16 + swz / 64; C = (st & 1) * 32 + (swz % 64) / 2; }
__host__ __device__ __forceinline__ int perm32(int rho) { const int n = rho >> 4, i = rho & 15; return 8 * (i >> 2) + 4 * n + (i & 3); }

struct Unit { int pm, pn; const char* A; const char* B; int slot; };

struct StaticOrder {
    static constexpr bool GATHER = false;
    int nM, nN, nwg, G, c; const char* A; const char* B; size_t tstepA, tstepB;
    __device__ void init(int M, int N, int G_, int c_, const void* A_, int lda, const void* B_, int ldb) { nM = M / BM; nN = N / BM; nwg = nM * nN; G = G_; c = c_; A = (const char*)A_; B = (const char*)B_; tstepA = (size_t)BM * lda * 2; tstepB = (size_t)BM * ldb * 2; }
    __device__ bool next(int i, Unit& u) const {
        const long L = (long)i * G + c; if (L >= nwg) return false;
        int wgid = (int)L; { const int q = nwg / NXCD, r = nwg % NXCD, xcd = wgid % NXCD, off = wgid / NXCD; wgid = (xcd < r ? xcd * (q + 1) : r * (q + 1) + (xcd - r) * q) + off; }
        const int nig = WGM * nN, gid = wgid / nig, fm = gid * WGM, gsz = (nM - fm) < WGM ? (nM - fm) : WGM;
        u.pm = fm + ((wgid % nig) % gsz); u.pn = (wgid % nig) / gsz; u.A = A + (size_t)u.pm * tstepA; u.B = B + (size_t)u.pn * tstepB; u.slot = 0; return true;
    }
    __device__ __forceinline__ unsigned row(const Unit&, int) const { return 0u; }
};

struct StaticOrderG : StaticOrder {
    static constexpr bool GATHER = true;
    __device__ bool next(int i, Unit& u) const { if (!StaticOrder::next(i, u)) return false; u.A = A; return true; }
    __device__ __forceinline__ unsigned row(const Unit& u, int r) const { return (unsigned)(u.pm * BM + r); }
};

template <class E_, class = void> struct EpiPf { static constexpr bool v = false; };
template <class E_> struct EpiPf<E_, decltype((void)E_::L2PF)> { static constexpr bool v = E_::L2PF; };
template <class E_, class = void> struct EpiLaneAsm { static constexpr bool v = false; };
template <class E_> struct EpiLaneAsm<E_, decltype((void)E_::LANEASM)> { static constexpr bool v = E_::LANEASM; };
template <class E_, class = void> struct EpiScaled { static constexpr bool v = false; };
template <class E_> struct EpiScaled<E_, decltype((void)E_::SCALED)> { static constexpr bool v = E_::SCALED; };
template <class E_, class = void> struct EpiMid { static constexpr bool v = false; };
template <class E_> struct EpiMid<E_, decltype((void)E_::MIDHOOK)> { static constexpr bool v = E_::MIDHOOK; };
template <class Epi, class Sched, bool ALIGN_EPI, bool FP8 = false>
__device__ __forceinline__ void gemm_phase(LAS unsigned char* lds, const int K, const int lda, const int ldb, const Sched& S, const Epi& E, const int tid_in, const long dA2 = 0, const long dB2 = 0) {
    constexpr bool MID = EpiMid<Epi>::v;
    int tid_ = tid_in; asm volatile("" : "+v"(tid_));
    const int tid = tid_, wid = __builtin_amdgcn_readfirstlane(tid >> 6), lane = tid & 63, wr = wid >> 2, wc = wid & 3, fr = lane & 15, fq = lane >> 4;
    int nt = K / BK; asm volatile("" : "+s"(nt));
    int sR[2], sC[2]; unsigned vB[2];
#pragma unroll
    for (int i = 0; i < 2; ++i) { int R, C; stage_rc(tid * 16 + i * 8192, R, C); sR[i] = R; sC[i] = C;
        int r0;
        if (Epi::BMAP == 2) { const int rho = R & 31; r0 = 64 * (R >> 5) + 16 * ((rho & 15) >> 2) + 4 * (rho >> 4) + (rho & 3); }
        else r0 = (Epi::BMAP == 1) ? ((R & ~31) + perm32(R & 31)) : R;
        vB[i] = (unsigned)(r0 * ldb + C) * 2u; }
    const size_t kstep = (size_t)(BK * 2);
    const size_t hstepB = (size_t)((Epi::BMAP == 2) ? 8 : HALF) * ldb * 2;
    const unsigned ldsw = (unsigned)wid * 1024u;
    const int aoff = lds_byte(wr * 64 + fr, fq * 8), boff = lds_byte(wc * 32 + fr, fq * 8);
#ifndef PF_TILES
#define PF_TILES 4
#endif
#ifndef PG8_AUX
#define PG8_AUX 1
#endif
#define PG8_SA(b, h) (((b) * 2 + (h)) * HTB)
#define PG8_SB(b, h) ((4 + (b) * 2 + (h)) * HTB)
#define PG8_STAGE(bufoff, gbase, v0, v1) do { \
        __builtin_amdgcn_global_load_lds((const unsigned*)((const char*)(gbase) + (v0)), (LAS unsigned*)(lds + (bufoff) + ldsw), 16, 0, PG8_AUX); \
        __builtin_amdgcn_global_load_lds((const unsigned*)((const char*)(gbase) + (v1)), (LAS unsigned*)(lds + (bufoff) + ldsw + 8192), 16, 0, PG8_AUX); } while (0)
#define PG8_LDA(dst, b, h) do { _Pragma("unroll") for (int m = 0; m < 4; ++m) _Pragma("unroll") for (int k = 0; k < 2; ++k) dst[m][k] = *(const LAS bf16x8*)(lds + PG8_SA(b, h) + aoff + m * 2048 + k * 1024); } while (0)
#define PG8_LDB(dst, b, h) do { _Pragma("unroll") for (int n = 0; n < 2; ++n) _Pragma("unroll") for (int k = 0; k < 2; ++k) dst[n][k] = *(const LAS bf16x8*)(lds + PG8_SB(b, h) + boff + n * 2048 + k * 1024); } while (0)
#define PG8_MMA(ai, bj, At, Bt) do { __builtin_amdgcn_s_setprio(1); _Pragma("unroll") for (int m = 0; m < 4; ++m) _Pragma("unroll") for (int n = 0; n < 2; ++n) { \
        if constexpr (FP8) { typedef int i32x8_ __attribute__((ext_vector_type(8))); typedef int i32x4_ __attribute__((ext_vector_type(4))); \
            const i32x4_ b0_ = __builtin_bit_cast(i32x4_, Bt[n][0]), b1_ = __builtin_bit_cast(i32x4_, Bt[n][1]), a0_ = __builtin_bit_cast(i32x4_, At[m][0]), a1_ = __builtin_bit_cast(i32x4_, At[m][1]); \
            const i32x8_ bw_ = (i32x8_){b0_[0], b0_[1], b0_[2], b0_[3], b1_[0], b1_[1], b1_[2], b1_[3]}, aw_ = (i32x8_){a0_[0], a0_[1], a0_[2], a0_[3], a1_[0], a1_[1], a1_[2], a1_[3]}; \
            if constexpr (EpiScaled<Epi>::v) acc[ai][bj][m][n] = __builtin_amdgcn_mfma_scale_f32_16x16x128_f8f6f4(bw_, aw_, acc[ai][bj][m][n], 0, 0, 0, 0x7f7f7f7f, 0, 0x7f7f7f7f); \
            else acc[ai][bj][m][n] = __builtin_amdgcn_mfma_scale_f32_16x16x128_f8f6f4(bw_, aw_, acc[ai][bj][m][n], 0, 0, 0, 0, 0, 0); } \
        else { _Pragma("unroll") for (int k = 0; k < 2; ++k) acc[ai][bj][m][n] = __builtin_amdgcn_mfma_f32_16x16x32_bf16(Bt[n][k], At[m][k], acc[ai][bj][m][n], 0, 0, 0); } } \
        __builtin_amdgcn_s_setprio(0); } while (0)
#define PG8_WAIT_V(n) asm volatile("s_waitcnt vmcnt(" #n ")" ::: "memory")
#define PG8_WAIT_L(n) asm volatile("s_waitcnt lgkmcnt(" #n ")" ::: "memory")
#define PG8_BAR __builtin_amdgcn_s_barrier()
#define PG8_SCHED __builtin_amdgcn_sched_barrier(0)
    Unit cur, nxt; int ui = 0;
    if (!S.next(0, cur)) return;
    f32x4 acc[2][2][4][2];
#pragma unroll
    for (int a = 0; a < 2; ++a)
#pragma unroll
        for (int b = 0; b < 2; ++b)
#pragma unroll
            for (int m = 0; m < 4; ++m)
#pragma unroll
                for (int n = 0; n < 2; ++n) acc[a][b][m][n] = (f32x4){0.f, 0.f, 0.f, 0.f};
    bf16x8 At[4][2], B0[2][2], B1[2][2];
    unsigned c00, c01, c10, c11;
    const unsigned lda2 = (unsigned)(lda * 2), sc0 = (unsigned)sC[0] * 2u, sc1 = (unsigned)sC[1] * 2u;
    if constexpr (Sched::GATHER) { c00 = S.row(cur, sR[0]) * lda2 + sc0; c01 = S.row(cur, sR[1]) * lda2 + sc1; c10 = S.row(cur, HALF + sR[0]) * lda2 + sc0; c11 = S.row(cur, HALF + sR[1]) * lda2 + sc1; }
    else { c00 = (unsigned)sR[0] * lda2 + sc0; c01 = (unsigned)sR[1] * lda2 + sc1; c10 = (unsigned)(HALF + sR[0]) * lda2 + sc0; c11 = (unsigned)(HALF + sR[1]) * lda2 + sc1; }
    const char* cA = cur.A; const char* cB = cur.B;
    PG8_STAGE(PG8_SB(0, 0), cB, vB[0], vB[1]); PG8_STAGE(PG8_SB(0, 1), cB + hstepB, vB[0], vB[1]); PG8_STAGE(PG8_SA(0, 0), cA, c00, c01); PG8_STAGE(PG8_SA(0, 1), cA, c10, c11);
    if (wr == 1) PG8_BAR;
    PG8_WAIT_V(2); PG8_BAR;
    PG8_STAGE(PG8_SB(1, 0), cB + kstep, vB[0], vB[1]); PG8_STAGE(PG8_SA(1, 0), cA + kstep, c00, c01); PG8_STAGE(PG8_SB(1, 1), cB + hstepB + kstep, vB[0], vB[1]);
    PG8_WAIT_V(6); PG8_BAR;
    for (;;) {
        const bool has_next = S.next(ui + 1, nxt);
        const char* nA = has_next ? nxt.A : cA; const char* nB = has_next ? nxt.B : cB;
#pragma unroll 1
        for (int t = 0; t < nt; t += 2) {
            const bool last = (t == nt - 2);
            const char* a1 = cA + (size_t)(t + 1) * kstep;
            const char* a2 = last ? nA : cA + (size_t)(t + 2) * kstep; const char* b2 = last ? nB : cB + (size_t)(t + 2) * kstep;
            if constexpr (MID) { const int nh = nt >> 1; const long dA = dA2 - (long)nh * (long)kstep, dB = dB2 - (long)nh * (long)kstep;
                if (t == nh) { unsigned tm; asm volatile("v_mbcnt_lo_u32_b32 %0, -1, 0\n\tv_mbcnt_hi_u32_b32 %0, -1, %0" : "=v"(tm)); E.mid(acc, cur, wr, wc, (int)(tm & 15u), (int)(tm >> 4)); }
                a1 += (t >= nh) ? dA : 0; const bool s2 = !last && t >= nh - 2; a2 += s2 ? dA : 0; b2 += s2 ? dB : 0; }
            const char* a3 = a2 + kstep; const char* b3 = b2 + kstep;
            PG8_LDB(B0, 0, 0); PG8_LDB(B1, 0, 1); PG8_SCHED; PG8_LDA(At, 0, 0); PG8_STAGE(PG8_SA(1, 1), a1, c10, c11);
            PG8_WAIT_V(8); PG8_WAIT_L(0); PG8_BAR; PG8_MMA(0, 0, At, B0); PG8_MMA(0, 1, At, B1); PG8_BAR; PG8_SCHED;
            if constexpr (Sched::GATHER) { if (last && has_next) {
                unsigned lz_; asm volatile("v_mbcnt_lo_u32_b32 %0, -1, 0\n\tv_mbcnt_hi_u32_b32 %0, -1, %0" : "=v"(lz_));
                const int tz_ = wid * 64 + (int)lz_; int R0_, C0_, R1_, C1_; stage_rc(tz_ * 16, R0_, C0_); stage_rc(tz_ * 16 + 8192, R1_, C1_);
                c00 = S.row(nxt, R0_) * lda2 + (unsigned)C0_ * 2u; c01 = S.row(nxt, R1_) * lda2 + (unsigned)C1_ * 2u; c10 = S.row(nxt, HALF + R0_) * lda2 + (unsigned)C0_ * 2u; c11 = S.row(nxt, HALF + R1_) * lda2 + (unsigned)C1_ * 2u; } }
            PG8_LDA(At, 0, 1); PG8_STAGE(PG8_SB(0, 0), b2, vB[0], vB[1]); PG8_STAGE(PG8_SB(0, 1), b2 + hstepB, vB[0], vB[1]); PG8_STAGE(PG8_SA(0, 0), a2, c00, c01);
            PG8_WAIT_V(8); PG8_WAIT_L(0); PG8_BAR; PG8_MMA(1, 0, At, B0); PG8_MMA(1, 1, At, B1); PG8_BAR; PG8_SCHED;
            PG8_LDB(B0, 1, 0); PG8_LDB(B1, 1, 1); PG8_SCHED; PG8_LDA(At, 1, 0); PG8_STAGE(PG8_SA(0, 1), a2, c10, c11);
            PG8_WAIT_V(8); PG8_WAIT_L(0); PG8_BAR; PG8_MMA(0, 0, At, B0); PG8_MMA(0, 1, At, B1); PG8_BAR; PG8_SCHED;
            PG8_LDA(At, 1, 1); PG8_STAGE(PG8_SB(1, 0), b3, vB[0], vB[1]); PG8_STAGE(PG8_SB(1, 1), b3 + hstepB, vB[0], vB[1]); PG8_STAGE(PG8_SA(1, 0), a3, c00, c01);
            PG8_WAIT_V(8); PG8_WAIT_L(0); PG8_BAR; PG8_MMA(1, 0, At, B0); PG8_MMA(1, 1, At, B1); PG8_BAR; PG8_SCHED;
        }
        if constexpr (ALIGN_EPI) { if (wr == 0) PG8_BAR; }
        if constexpr (EpiLaneAsm<Epi>::v) { unsigned le_; asm volatile("v_mbcnt_lo_u32_b32 %0, -1, 0\n\tv_mbcnt_hi_u32_b32 %0, -1, %0" : "=v"(le_)); E(acc, cur, wr, wc, (int)(le_ & 15u), (int)(le_ >> 4)); }
        else E(acc, cur, wr, wc, fr, fq);
        if (!has_next) break;
        if constexpr (Sched::GATHER && EpiPf<Epi>::v) { {
            unsigned ln_; asm volatile("v_mbcnt_lo_u32_b32 %0, -1, 0\n\tv_mbcnt_hi_u32_b32 %0, -1, %0" : "=v"(ln_));
            const int L = (wid & 3) * 64 + (int)ln_;
            const char* pbase = (wid >= 4) ? nB : nA;
            const unsigned poff = (wid >= 4) ? (unsigned)L * (unsigned)(ldb * 2) : S.row(nxt, L) * lda2;
            LAS unsigned* dump = (LAS unsigned*)(lds + PF_OFF + wid * 256);
            if (2 < nt) __builtin_amdgcn_global_load_lds((const unsigned*)(pbase + poff), dump, 4, 2 * 128, PG8_AUX);
            if (3 < nt) __builtin_amdgcn_global_load_lds((const unsigned*)(pbase + poff), dump, 4, 3 * 128, PG8_AUX);
            if (PF_TILES > 2 && 4 < nt) __builtin_amdgcn_global_load_lds((const unsigned*)(pbase + poff), dump, 4, 4 * 128, PG8_AUX);
            if (PF_TILES > 3 && 5 < nt) __builtin_amdgcn_global_load_lds((const unsigned*)(pbase + poff), dump, 4, 5 * 128, PG8_AUX); } }
#pragma unroll
        for (int a = 0; a < 2; ++a)
#pragma unroll
            for (int b = 0; b < 2; ++b)
#pragma unroll
                for (int m = 0; m < 4; ++m)
#pragma unroll
                    for (int n = 0; n < 2; ++n) acc[a][b][m][n] = (f32x4){0.f, 0.f, 0.f, 0.f};
        cur = nxt; cA = nA; cB = nB; ++ui;
        if constexpr (ALIGN_EPI) { if (wr == 1) PG8_BAR; }
    }
    PG8_WAIT_V(0);
    if constexpr (!ALIGN_EPI) { if (wr == 0) PG8_BAR; }
    PG8_BAR;
#undef PG8_SA
#undef PG8_SB
#undef PG8_STAGE
#undef PG8_LDA
#undef PG8_LDB
#undef PG8_MMA
#undef PG8_WAIT_V
#undef PG8_WAIT_L
#undef PG8_BAR
#undef PG8_SCHED
}

__device__ __forceinline__ u32x4 lane_tr(const u32x4 w, const int sa) { u32x4 r; r.x = (unsigned)__builtin_amdgcn_ds_bpermute(sa, (int)w.x); r.y = (unsigned)__builtin_amdgcn_ds_bpermute(sa, (int)w.y); r.z = (unsigned)__builtin_amdgcn_ds_bpermute(sa, (int)w.z); r.w = (unsigned)__builtin_amdgcn_ds_bpermute(sa, (int)w.w); return r; }
__device__ __forceinline__ f32x4 lane_trf(const f32x4 v, const int sa) { return __builtin_bit_cast(f32x4, lane_tr(__builtin_bit_cast(u32x4, v), sa)); }
#define PG8_EPI_LANES int lane_ = fq * 16 + fr; asm volatile("" : "+v"(lane_));     \
    const int sa_ = (((lane_ & 3) << 4) + (lane_ >> 2)) << 2, tr_ = lane_ >> 2, tq_ = lane_ & 3
struct EpiProj {
    static constexpr int BMAP = 1;
    bf16_t* O; int pn_split, pn_add; float wscale;
    __device__ __forceinline__ void operator()(const f32x4 (&acc)[2][2][4][2], const Unit& u, int wr, int wc, int fr, int fq) const {
        PG8_EPI_LANES;
        const int pn = u.pn + (u.pn >= pn_split ? pn_add : 0);
        const int row0 = u.pm * BM + wr * 64 + tr_, col0 = pn * BM + wc * 32 + 8 * tq_, sec = pn >> 2;
        const float sc = wscale * ((sec == 0) ? QA_SCALE : ((sec == 3) ? QB_SCALE : 1.0f)); const bool sig = sec >= 6;
#pragma unroll
        for (int ai = 0; ai < 2; ++ai)
#pragma unroll
            for (int m = 0; m < 4; ++m) { bf16_t* rowp = O + (size_t)(row0 + ai * HALF + m * 16) * NPROJ + col0;
#pragma unroll
                for (int bj = 0; bj < 2; ++bj) { f32x4 v0 = acc[ai][bj][m][0], v1 = acc[ai][bj][m][1];
                    if (sig) { v0 = (f32x4){sigmoidf_fast(v0[0]), sigmoidf_fast(v0[1]), sigmoidf_fast(v0[2]), sigmoidf_fast(v0[3])}; v1 = (f32x4){sigmoidf_fast(v1[0]), sigmoidf_fast(v1[1]), sigmoidf_fast(v1[2]), sigmoidf_fast(v1[3])}; }
                    else { v0 = v0 * sc; v1 = v1 * sc; }
                    u32x4 w; w.x = cvt_pk_bf16(v0[0], v0[1]); w.y = cvt_pk_bf16(v0[2], v0[3]); w.z = cvt_pk_bf16(v1[0], v1[1]); w.w = cvt_pk_bf16(v1[2], v1[3]);
                    *(u32x4*)(rowp + bj * HALF) = lane_tr(w, sa_); } }
    }
};
template <bool SIG> struct EpiProjB {
    static constexpr int BMAP = 1;
    bf16_t* O; float wscale;
    __device__ __forceinline__ void operator()(const f32x4 (&acc)[2][2][4][2], const Unit& u, int wr, int wc, int fr, int fq) const {
        PG8_EPI_LANES;
        const int pn = u.pn + (SIG ? 24 : 0);
        const int row0 = u.pm * BM + wr * 64 + tr_, col0 = pn * BM + wc * 32 + 8 * tq_;
        const float sc = wscale * ((!SIG && u.pn < 4) ? QA_SCALE : ((!SIG && u.pn >= 12 && u.pn < 16) ? QB_SCALE : 1.0f));
#pragma unroll
        for (int ai = 0; ai < 2; ++ai)
#pragma unroll
            for (int m = 0; m < 4; ++m) { bf16_t* rowp = O + (size_t)(row0 + ai * HALF + m * 16) * NPROJ + col0;
#pragma unroll
                for (int bj = 0; bj < 2; ++bj) { f32x4 v0 = acc[ai][bj][m][0] * sc, v1 = acc[ai][bj][m][1] * sc;
                    if (SIG) { v0 = (f32x4){sigmoidf_fast(v0[0]), sigmoidf_fast(v0[1]), sigmoidf_fast(v0[2]), sigmoidf_fast(v0[3])}; v1 = (f32x4){sigmoidf_fast(v1[0]), sigmoidf_fast(v1[1]), sigmoidf_fast(v1[2]), sigmoidf_fast(v1[3])}; }
                    u32x4 w; w.x = cvt_pk_bf16(v0[0], v0[1]); w.y = cvt_pk_bf16(v0[2], v0[3]); w.z = cvt_pk_bf16(v1[0], v1[1]); w.w = cvt_pk_bf16(v1[2], v1[3]);
                    *(u32x4*)(rowp + bj * HALF) = lane_tr(w, sa_); }
                if (SIG) __builtin_amdgcn_sched_barrier(0); }
    }
};
template <bool ADD, bool OUT8 = false> struct EpiGate {
    static constexpr int BMAP = 1;
    const bf16_t* G; int ldg; bf16_t* O; int ldo; float wscale; unsigned char* O8;
    __device__ __forceinline__ void operator()(const f32x4 (&acc)[2][2][4][2], const Unit& u, int wr, int wc, int fr, int fq) const {
        PG8_EPI_LANES;
        const int row0 = u.pm * BM + wr * 64 + tr_, col0 = u.pn * BM + wc * 32 + 8 * tq_;
#pragma unroll
        for (int ai = 0; ai < 2; ++ai)
#pragma unroll
            for (int m = 0; m < 4; ++m) { const size_t r = (size_t)(row0 + ai * HALF + m * 16);
#pragma unroll
                for (int bj = 0; bj < 2; ++bj) { const f32x4 v0 = lane_trf(acc[ai][bj][m][0], sa_) * wscale, v1 = lane_trf(acc[ai][bj][m][1], sa_) * wscale;
                    const u32x4 g = *(const u32x4*)(G + r * ldg + col0 + bj * HALF);
                    float o0 = bf_lo(g.x) * v0[0], o1 = bf_hi(g.x) * v0[1], o2 = bf_lo(g.y) * v0[2], o3 = bf_hi(g.y) * v0[3];
                    float o4 = bf_lo(g.z) * v1[0], o5 = bf_hi(g.z) * v1[1], o6 = bf_lo(g.w) * v1[2], o7 = bf_hi(g.w) * v1[3];
                    bf16_t* op = O + r * ldo + col0 + bj * HALF;
                    if (ADD) { const u32x4 p = *(const u32x4*)op; o0 += bf_lo(p.x); o1 += bf_hi(p.x); o2 += bf_lo(p.y); o3 += bf_hi(p.y); o4 += bf_lo(p.z); o5 += bf_hi(p.z); o6 += bf_lo(p.w); o7 += bf_hi(p.w); }
                    if (OUT8) { u32x2 w8; w8.x = pk4_fp8(o0 * MG_SCALE, o1 * MG_SCALE, o2 * MG_SCALE, o3 * MG_SCALE); w8.y = pk4_fp8(o4 * MG_SCALE, o5 * MG_SCALE, o6 * MG_SCALE, o7 * MG_SCALE); *(u32x2*)(O8 + r * ldo + col0 + bj * HALF) = w8; }
                    else { u32x4 w; w.x = cvt_pk_bf16(o0, o1); w.y = cvt_pk_bf16(o2, o3); w.z = cvt_pk_bf16(o4, o5); w.w = cvt_pk_bf16(o6, o7);
                    *(u32x4*)op = w; } } }
    }
};
struct EpiGate2 {
    static constexpr int BMAP = 1; static constexpr bool MIDHOOK = true; static constexpr bool L2PF = true;
    const bf16_t* GA; const bf16_t* GB; int ldg; int ldo; float wscale; unsigned char* O8;
    __device__ __forceinline__ void mid(f32x4 (&acc)[2][2][4][2], const Unit& u, int wr, int wc, int fr, int fq) const {
        const int row0 = u.pm * BM + wr * 64 + fr, col0 = u.pn * BM + wc * 32 + 8 * fq;
#pragma unroll
        for (int ai = 0; ai < 2; ++ai)
#pragma unroll
            for (int m = 0; m < 4; ++m) { const size_t r = (size_t)(row0 + ai * HALF + m * 16);
#pragma unroll
                for (int bj = 0; bj < 2; ++bj) { const u32x4 a = *(const u32x4*)(GA + r * ldg + col0 + bj * HALF), b = *(const u32x4*)(GB + r * ldg + col0 + bj * HALF);
                    const f32x4 q0 = (f32x4){bf_lo(a.x) * __builtin_amdgcn_rcpf(fmaxf(bf_lo(b.x), 1e-20f)), bf_hi(a.x) * __builtin_amdgcn_rcpf(fmaxf(bf_hi(b.x), 1e-20f)), bf_lo(a.y) * __builtin_amdgcn_rcpf(fmaxf(bf_lo(b.y), 1e-20f)), bf_hi(a.y) * __builtin_amdgcn_rcpf(fmaxf(bf_hi(b.y), 1e-20f))};
                    const f32x4 q1 = (f32x4){bf_lo(a.z) * __builtin_amdgcn_rcpf(fmaxf(bf_lo(b.z), 1e-20f)), bf_hi(a.z) * __builtin_amdgcn_rcpf(fmaxf(bf_hi(b.z), 1e-20f)), bf_lo(a.w) * __builtin_amdgcn_rcpf(fmaxf(bf_lo(b.w), 1e-20f)), bf_hi(a.w) * __builtin_amdgcn_rcpf(fmaxf(bf_hi(b.w), 1e-20f))};
                    acc[ai][bj][m][0] = acc[ai][bj][m][0] * q0; acc[ai][bj][m][1] = acc[ai][bj][m][1] * q1; }
                __builtin_amdgcn_sched_barrier(0); }
    }
    __device__ __forceinline__ void operator()(const f32x4 (&acc)[2][2][4][2], const Unit& u, int wr, int wc, int fr, int fq) const {
        PG8_EPI_LANES;
        const int row0 = u.pm * BM + wr * 64 + tr_, col0 = u.pn * BM + wc * 32 + 8 * tq_;
        const float ws8 = wscale * MG_SCALE;
#pragma unroll
        for (int ai = 0; ai < 2; ++ai)
#pragma unroll
            for (int m = 0; m < 4; ++m) { const size_t r = (size_t)(row0 + ai * HALF + m * 16);
#pragma unroll
                for (int bj = 0; bj < 2; ++bj) { const f32x4 v0 = lane_trf(acc[ai][bj][m][0], sa_) * ws8, v1 = lane_trf(acc[ai][bj][m][1], sa_) * ws8;
                    const u32x4 g = *(const u32x4*)(GB + r * ldg + col0 + bj * HALF);
                    u32x2 w8; w8.x = pk4_fp8(fmaxf(bf_lo(g.x), 1e-20f) * v0[0], fmaxf(bf_hi(g.x), 1e-20f) * v0[1], fmaxf(bf_lo(g.y), 1e-20f) * v0[2], fmaxf(bf_hi(g.y), 1e-20f) * v0[3]);
                    w8.y = pk4_fp8(fmaxf(bf_lo(g.z), 1e-20f) * v1[0], fmaxf(bf_hi(g.z), 1e-20f) * v1[1], fmaxf(bf_lo(g.w), 1e-20f) * v1[2], fmaxf(bf_hi(g.w), 1e-20f) * v1[3]);
                    *(u32x2*)(O8 + r * ldo + col0 + bj * HALF) = w8; } }
    }
};
struct EpiRes {
    static constexpr int BMAP = 1;
    const float* X; const float* gt  ; bf16_t* out; float wscale;
    __device__ __forceinline__ void operator()(const f32x4 (&acc)[2][2][4][2], const Unit& u, int wr, int wc, int fr, int fq) const {
        PG8_EPI_LANES;
        const int row0 = u.pm * BM + wr * 64 + tr_, col0 = u.pn * BM + wc * 32 + 8 * tq_; const float* g = gt + (size_t)(u.pm >> 3) * NMOD;
        f32x4 gv[2][2];
#pragma unroll
        for (int bj = 0; bj < 2; ++bj)
#pragma unroll
            for (int n = 0; n < 2; ++n) gv[bj][n] = *(const f32x4*)(g + col0 + bj * HALF + n * 4);
#pragma unroll
        for (int ai = 0; ai < 2; ++ai)
#pragma unroll
            for (int m = 0; m < 4; ++m) { const size_t off = (size_t)(row0 + ai * HALF + m * 16) * DM + col0;
#pragma unroll
                for (int bj = 0; bj < 2; ++bj) { const f32x4 x0 = __builtin_nontemporal_load((const f32x4*)(X + off + bj * HALF)), x1 = __builtin_nontemporal_load((const f32x4*)(X + off + bj * HALF + 4));
                    const f32x4 h0 = x0 + gv[bj][0] * (lane_trf(acc[ai][bj][m][0], sa_) * wscale), h1 = x1 + gv[bj][1] * (lane_trf(acc[ai][bj][m][1], sa_) * wscale);
                    u32x4 w; w.x = cvt_pk_bf16(h0[0], h0[1]); w.y = cvt_pk_bf16(h0[2], h0[3]); w.z = cvt_pk_bf16(h1[0], h1[1]); w.w = cvt_pk_bf16(h1[2], h1[3]);
                    *(u32x4*)(out + off + bj * HALF) = w; } }
    }
};
struct EpiSwiGLU8 {
    static constexpr int BMAP = 1; static constexpr bool LANEASM = true;
    unsigned char* O; float wscale;
    __device__ __forceinline__ void operator()(const f32x4 (&acc)[2][2][4][2], const Unit& u, int wr, int wc, int fr, int fq) const {
        PG8_EPI_LANES;
        const int row0 = u.pm * BM + wr * 64 + tr_, col0 = u.pn * HALF + wc * 32 + 8 * tq_;
#pragma unroll
        for (int ai = 0; ai < 2; ++ai)
#pragma unroll
            for (int m = 0; m < 4; ++m) { float h[8];
#pragma unroll
                for (int n = 0; n < 2; ++n)
#pragma unroll
                    for (int j = 0; j < 4; ++j) { const float g = acc[ai][0][m][n][j] * wscale, up = acc[ai][1][m][n][j] * wscale; h[4 * n + j] = g * sigmoidf_fast(g) * up; }
                u32x2 w; w.x = pk4_fp8(h[0], h[1], h[2], h[3]); w.y = pk4_fp8(h[4], h[5], h[6], h[7]);
                u32x2 t; t.x = (unsigned)__builtin_amdgcn_ds_bpermute(sa_, (int)w.x); t.y = (unsigned)__builtin_amdgcn_ds_bpermute(sa_, (int)w.y);
                *(u32x2*)(O + (size_t)(row0 + ai * HALF + m * 16) * DE + col0) = t; }
    }
};
struct EpiYs8 {
    static constexpr int BMAP = 2; static constexpr bool L2PF = true;
    unsigned char* O; float wscale;
    __device__ __forceinline__ void operator()(const f32x4 (&acc)[2][2][4][2], const Unit& u, int wr, int wc, int fr, int fq) const {
        PG8_EPI_LANES;
        const int row0 = u.pm * BM + wr * 64 + tr_, col0 = u.pn * BM + wc * 64 + 16 * tq_;
#pragma unroll
        for (int ai = 0; ai < 2; ++ai)
#pragma unroll
            for (int m = 0; m < 4; ++m) { u32x4 w;
                { const f32x4 a = acc[ai][0][m][0] * wscale, b = acc[ai][0][m][1] * wscale, c = acc[ai][1][m][0] * wscale, d = acc[ai][1][m][1] * wscale;
                  w.x = pk4_fp8(a[0], a[1], a[2], a[3]); w.y = pk4_fp8(b[0], b[1], b[2], b[3]); w.z = pk4_fp8(c[0], c[1], c[2], c[3]); w.w = pk4_fp8(d[0], d[1], d[2], d[3]); }
                *(u32x4*)(O + (size_t)(row0 + ai * HALF + m * 16) * DM + col0) = lane_tr(w, sa_); }
    }
};
}

#define XB_TMO      128
#define XB_XCNT(j)  (256  + 64 * (j))
#define XB_XSUB(j)  (1280 + 64 * (j))
#define XB_XGEN(j)  (2304 + 64 * (j))
#define XB_TOP      3328
#define XB_TOPGEN   3392
#define XCD_BAR_WORDS 3456
#define XB_SPIN_CAP (1u << 18)
__device__ __forceinline__ unsigned xb_ld(unsigned* p)              { return __hip_atomic_load(p, __ATOMIC_RELAXED, __HIP_MEMORY_SCOPE_AGENT); }
__device__ __forceinline__ unsigned xb_add(unsigned* p, unsigned v) { return __hip_atomic_fetch_add(p, v, __ATOMIC_RELAXED, __HIP_MEMORY_SCOPE_AGENT); }
__device__ __forceinline__ unsigned xb_xcc_id() { return (unsigned)__builtin_amdgcn_s_getreg((3 << 11) | 20) & 0xFu; }
#define XB_SPIN(cond, bar) do { unsigned _sp = 0; while (cond) { __builtin_amdgcn_s_sleep(1); \
    if ((++_sp & 255u) == 0u) { if (xb_ld(&(bar)[XB_TMO])) break; if (_sp > XB_SPIN_CAP) { atomicAdd(&(bar)[XB_TMO], 1u); break; } } } } while (0)
struct XcdBarrier { unsigned* bar; unsigned x; volatile LAS unsigned* st; };
__device__ __forceinline__ XcdBarrier xcd_barrier_post(unsigned* bar, volatile LAS unsigned* st) {
    XcdBarrier b; b.bar = bar; b.x = xb_xcc_id(); b.st = st;
    if (threadIdx.x == 0) (void)xb_add(&bar[XB_XCNT(b.x)], 1u);
    return b;
}
__device__ __forceinline__ void xcd_barrier_complete(unsigned* bar, unsigned x, unsigned& nloc, unsigned& nx) {
    const unsigned G = gridDim.x * gridDim.y * gridDim.z;
    unsigned sum, cnt, mine, sp = 0u;
    for (;;) {
        sum = 0u; cnt = 0u; mine = 0u;
#pragma unroll
        for (unsigned j = 0; j < 16; ++j) { const unsigned c = xb_ld(&bar[XB_XCNT(j)]); sum += c; cnt += (c > 0u) ? 1u : 0u; mine = (j == x) ? c : mine; }
        if (sum == G) break;
        __builtin_amdgcn_s_sleep(1);
        if ((++sp & 255u) == 0u) { if (xb_ld(&bar[XB_TMO])) break; if (sp > XB_SPIN_CAP) { atomicAdd(&bar[XB_TMO], 1u); break; } }
    }
    nloc = mine > 0u ? mine : 1u; nx = cnt > 0u ? cnt : 1u;
}
__device__ __forceinline__ void xcd_barrier(const XcdBarrier& b, const int tidx) {
    asm volatile("s_waitcnt vmcnt(0)" ::: "memory");
    __syncthreads();
    if (tidx == 0) {
        unsigned* bar = b.bar;
        __builtin_amdgcn_s_waitcnt(0);
        unsigned nloc = b.st[0], nx = b.st[1];
        if (nloc == 0u) { xcd_barrier_complete(bar, b.x, nloc, nx); b.st[0] = nloc; b.st[1] = nx; }
        const unsigned old = xb_add(&bar[XB_XSUB(b.x)], 1u);
        const unsigned gen = old / nloc;
        if (old + 1u == (gen + 1u) * nloc) {
            __builtin_amdgcn_fence(__ATOMIC_RELEASE, "agent");
            asm volatile("s_waitcnt vmcnt(0)" ::: "memory");
            const unsigned og = xb_add(&bar[XB_TOP], 1u);
            const unsigned tg = og / nx;
            if (og + 1u == (tg + 1u) * nx) xb_add(&bar[XB_TOPGEN], 1u);
            else XB_SPIN(xb_ld(&bar[XB_TOPGEN]) == tg, bar);
            __builtin_amdgcn_fence(__ATOMIC_ACQUIRE, "agent");
            xb_add(&bar[XB_XGEN(b.x)], 1u);
            asm volatile("s_waitcnt vmcnt(0)" ::: "memory");
        } else {
            XB_SPIN(xb_ld(&bar[XB_XGEN(b.x)]) == gen, bar);
            __builtin_amdgcn_fence(__ATOMIC_ACQUIRE, "agent");
            asm volatile("s_waitcnt vmcnt(0)" ::: "memory");
        }
    }
    __syncthreads();
}

struct Args {
    const float* x; const float* c; const float* w_ada; const float* b_ada; const float* g_attn; const float* w_in; const float* lambda_qk; const float* t5_bias; const float* rel_bias;
    const float* w_up_a; const float* w_up_b; const float* w_o; const float* g_moe; const float* w_router; const float* router_bias; const float* w_exp_gate; const float* w_exp_up; const float* w_exp_down;
    const float* w_sh_gate; const float* w_sh_up; const float* w_sh_down; const float* g_final;
    float* out; unsigned char* ws; int ph_lo, ph_hi;
};

__device__ __forceinline__ void p0_ada_item(const Args& a, float* part, LAS float* scr, int item, int lane) {
    const int cg = item % 48, kc = item / 48, n0 = 256 * cg + 4 * lane;
#pragma unroll
    for (int b = 0; b < 8; ++b) { const float cv = a.c[b * DM + 64 * kc + lane]; scr[lane * 8 + b] = cv * sigmoidf_fast(cv); }
    LDS_WAIT(); asm volatile("" ::: "memory");
    f32x4 acc[8];
#pragma unroll
    for (int b = 0; b < 8; ++b) acc[b] = (f32x4){0.f, 0.f, 0.f, 0.f};
    const float* wp = a.w_ada + (size_t)(64 * kc) * NMOD + n0;
#pragma unroll 16
    for (int kk = 0; kk < 64; ++kk) { const f32x4 w = __builtin_nontemporal_load((const f32x4*)(wp + (size_t)kk * NMOD));
        const f32x4 s0 = *(const LAS f32x4*)(scr + kk * 8), s1 = *(const LAS f32x4*)(scr + kk * 8 + 4);
        acc[0] += w * s0[0]; acc[1] += w * s0[1]; acc[2] += w * s0[2]; acc[3] += w * s0[3]; acc[4] += w * s1[0]; acc[5] += w * s1[1]; acc[6] += w * s1[2]; acc[7] += w * s1[3]; }
#pragma unroll
    for (int b = 0; b < 8; ++b) *(f32x4*)(part + ((size_t)(kc * 8 + b) * NMOD + n0)) = acc[b];
    LDS_WAIT(); asm volatile("" ::: "memory");
}
struct P0Item { const float* W; int K, N; unsigned char* dst; int mode; float sc; int item; int row_off; };
__device__ __forceinline__ P0Item p0_decode(const Args& a, int r) {
    unsigned char* ws = a.ws; P0Item t;
    constexpr int I_IN = 32 * 160, I_UP = 16 * 32, I_O = 32 * 32, I_EG = 32 * 8, I_ED = 8 * 32;
    if (r < I_IN) {
        t = P0Item{a.w_in, DM, NPROJ, ws + WS_WIN, 0, WINB_SCALE, r, 0}; return t; } r -= I_IN;
    if (r < I_UP) { t = P0Item{a.w_up_a, 1024, DM, ws + WS_WUA, 0, WUA_SCALE, r, 0}; return t; } r -= I_UP;
    if (r < I_UP) { t = P0Item{a.w_up_b, 1024, DM, ws + WS_WUB, 0, WUB_SCALE, r, 0}; return t; } r -= I_UP;
    if (r < I_O) { t = P0Item{a.w_o, DM, DM, ws + WS_WO, 0, WO_SCALE, r, 0}; return t; } r -= I_O;
    if (r < NEX * 2 * I_EG) { const int e = r / (2 * I_EG), q = r % (2 * I_EG), up = q / I_EG;
        const float* W = (e < NE) ? ((up ? a.w_exp_up : a.w_exp_gate) + (size_t)e * DM * DE) : (up ? a.w_sh_up : a.w_sh_gate);
        t = P0Item{W, DM, DE, ws + WS_WGU + (size_t)e * 1024 * DM, up ? 2 : 1, WGU_SCALE, q % I_EG, 0}; return t; } r -= NEX * 2 * I_EG;
    if (r < NEX * I_ED) { const int e = r / I_ED; const float* W = (e < NE) ? (a.w_exp_down + (size_t)e * DE * DM) : a.w_sh_down;
        t = P0Item{W, DE, DM, ws + WS_WD + (size_t)e * DM * DE, 0, WD_SCALE, r % I_ED, 0}; return t; } r -= NEX * I_ED;
    t = P0Item{a.w_router, DM, NE, ws + WS_WRT, 0, 0.f, r, 0}; return t;
}
#define P0_LOAD(T, tv) do { const int nkb_ = (T).K / 64, k0_ = 64 * ((T).item % nkb_), n0_ = 64 * ((T).item / nkb_);     \
        const float* wp_ = (T).W + (size_t)(k0_ + (lane >> 4)) * (T).N + n0_ + 4 * (lane & 15); \
        _Pragma("unroll") for (int i_ = 0; i_ < 16; ++i_) { const float* p_ = wp_ + (size_t)(4 * i_) * (T).N; asm volatile("global_load_dwordx4 %0, %1, off nt" : "=v"(tv[i_]) : "v"(p_) : "memory"); } } while (0)
#define P0_WAIT(tv, N) asm volatile("s_waitcnt vmcnt(" #N ")" : "+v"(tv[0]), "+v"(tv[1]), "+v"(tv[2]), "+v"(tv[3]), "+v"(tv[4]), "+v"(tv[5]), "+v"(tv[6]), "+v"(tv[7]), "+v"(tv[8]), "+v"(tv[9]), "+v"(tv[10]), "+v"(tv[11]), "+v"(tv[12]), "+v"(tv[13]), "+v"(tv[14]), "+v"(tv[15]) :: "memory")
__device__ __forceinline__ void p0_emit(const P0Item& T, const f32x4 (&tv)[16], LAS float* scr, int lane) {
    const int nkb = T.K / 64, k0 = 64 * (T.item % nkb), n0 = 64 * (T.item / nkb);
#pragma unroll
    for (int i = 0; i < 16; ++i) { LAS float* d = scr + (4 * i + (lane >> 4)) * 65 + 4 * (lane & 15); d[0] = tv[i].x; d[1] = tv[i].y; d[2] = tv[i].z; d[3] = tv[i].w; }
    LDS_WAIT(); asm volatile("" ::: "memory");
    const int r0 = T.row_off + ((T.mode == 0) ? n0 : ((n0 >> 7) * 256 + (n0 & 127) + (T.mode == 2 ? 128 : 0)));
    if (T.sc == 0.f) { const int c = lane & 7;
#pragma unroll
        for (int j = 0; j < 8; ++j) { const int n = (lane >> 3) + 8 * j; const LAS float* sp = scr + (8 * c) * 65 + n;
            u32x4 o; o.x = cvt_pk_bf16(sp[0 * 65], sp[1 * 65]); o.y = cvt_pk_bf16(sp[2 * 65], sp[3 * 65]); o.z = cvt_pk_bf16(sp[4 * 65], sp[5 * 65]); o.w = cvt_pk_bf16(sp[6 * 65], sp[7 * 65]);
            *(u32x4*)((bf16_t*)T.dst + (size_t)(r0 + n) * T.K + k0 + 8 * c) = o; } }
    else { const float sc = T.sc; const int kq = lane & 3;
#pragma unroll
        for (int j = 0; j < 4; ++j) { const int n = (lane >> 2) + 16 * j; const LAS float* sp = scr + (16 * kq) * 65 + n;
            u32x4 o;
            o.x = pk4_fp8(sp[0 * 65] * sc, sp[1 * 65] * sc, sp[2 * 65] * sc, sp[3 * 65] * sc);     o.y = pk4_fp8(sp[4 * 65] * sc, sp[5 * 65] * sc, sp[6 * 65] * sc, sp[7 * 65] * sc);
            o.z = pk4_fp8(sp[8 * 65] * sc, sp[9 * 65] * sc, sp[10 * 65] * sc, sp[11 * 65] * sc);   o.w = pk4_fp8(sp[12 * 65] * sc, sp[13 * 65] * sc, sp[14 * 65] * sc, sp[15 * 65] * sc);
            *(u32x4*)(T.dst + (size_t)(r0 + n) * T.K + k0 + 16 * kq) = o; } }
    LDS_WAIT(); asm volatile("" ::: "memory");
}
__device__ __forceinline__ void p0_prologue(const Args& a, LAS unsigned char* lds, int wave, int lane, int G) {
    LAS float* scr = (LAS float*)(lds + wave * 16640);
    const int gw = blockIdx.x * NWAVES + wave, NGW = G * NWAVES;
    constexpr int I_ADA = 48 * 32, I_IN = 32 * 160, I_UP = 16 * 32, I_O = 32 * 32, I_EG = 32 * 8, I_ED = 8 * 32, I_R = 32 * 1;
    constexpr int NTR = I_IN + 2 * I_UP + I_O + NEX * (2 * I_EG + I_ED) + I_R;
    int it = gw;
    for (; it < I_ADA; it += NGW) p0_ada_item(a, (float*)(a.ws + WS_PART), scr, it, lane);
    it -= I_ADA;
    if (it >= NTR) return;
    f32x4 tvC[16], tvN[16];
    P0Item TC = p0_decode(a, it), TN = TC;
    P0_LOAD(TC, tvC); P0_WAIT(tvC, 0);
    for (;;) {
        const bool hasN = it + NGW < NTR;
        if (hasN) { TN = p0_decode(a, it + NGW); P0_LOAD(TN, tvN); }
        p0_emit(TC, tvC, scr, lane);
        if (!hasN) break;
        P0_WAIT(tvN, 4);
#pragma unroll
        for (int i = 0; i < 16; ++i) tvC[i] = tvN[i];
        TC = TN; it += NGW;
    }
}
__device__ __forceinline__ void p1_mod_reduce(const Args& a, int G) {
    const float* part = (const float*)(a.ws + WS_PART); float* mod = (float*)(a.ws + WS_MOD);
    for (int i = blockIdx.x * 512 + threadIdx.x; i < NB * NMOD; i += G * 512) { const int n = i % NMOD; float s = a.b_ada[n];
#pragma unroll 8
        for (int kc = 0; kc < 32; ++kc) s += __builtin_nontemporal_load(part + (size_t)kc * NB * NMOD + i);
        mod[i] = s; }
}
template <bool W8, bool XBF, bool WB = true> __device__ __forceinline__ void norm_rows2_mod_bf16(const float* x0, const float* x1, const float* g, const float* sc, const float* sh, bf16_t* o0, bf16_t* o1, int lane, unsigned char* p0 = nullptr, unsigned char* p1 = nullptr) {
    const f32x4* xr0 = (const f32x4*)x0 + lane; const f32x4* xr1 = (const f32x4*)x1 + lane;
    f32x4 v0[8], v1[8]; float s0 = 0.f, s1 = 0.f;
    if (XBF) { const u32x2* b0 = (const u32x2*)x0 + lane; const u32x2* b1 = (const u32x2*)x1 + lane;
#pragma unroll
        for (int j = 0; j < 8; ++j) { const u32x2 a = b0[64 * j], c = b1[64 * j]; v0[j] = (f32x4){bf_lo(a.x), bf_hi(a.x), bf_lo(a.y), bf_hi(a.y)}; v1[j] = (f32x4){bf_lo(c.x), bf_hi(c.x), bf_lo(c.y), bf_hi(c.y)}; } }
    else {
#pragma unroll
        for (int j = 0; j < 8; ++j) { v0[j] = __builtin_nontemporal_load(xr0 + 64 * j); v1[j] = __builtin_nontemporal_load(xr1 + 64 * j); } }
#pragma unroll
    for (int j = 0; j < 8; ++j) { s0 += (v0[j].x * v0[j].x + v0[j].y * v0[j].y) + (v0[j].z * v0[j].z + v0[j].w * v0[j].w); s1 += (v1[j].x * v1[j].x + v1[j].y * v1[j].y) + (v1[j].z * v1[j].z + v1[j].w * v1[j].w); }
#pragma unroll
    for (int o = 1; o < 64; o <<= 1) { s0 += __shfl_xor(s0, o); s1 += __shfl_xor(s1, o); }
    const float r0 = 1.0f / sqrtf(s0 * (1.0f / DM) + 1e-6f), r1 = 1.0f / sqrtf(s1 * (1.0f / DM) + 1e-6f);
    u32x2* q0 = (u32x2*)o0 + lane; u32x2* q1 = (u32x2*)o1 + lane;
    f32x4 mm[8], hv[8];
#pragma unroll
    for (int j = 0; j < 8; ++j) { const f32x4 gg = ((const f32x4*)g)[lane + 64 * j], ss = ((const f32x4*)sc)[lane + 64 * j]; hv[j] = ((const f32x4*)sh)[lane + 64 * j]; mm[j] = gg * (ss + 1.0f); }
#pragma unroll
    for (int j = 0; j < 8; ++j) { const f32x4 m = mm[j], hh = hv[j];
        const f32x4 y0 = v0[j] * r0 * m + hh, y1 = v1[j] * r1 * m + hh;
        if (WB) { u32x2 w; w.x = cvt_pk_bf16(y0.x, y0.y); w.y = cvt_pk_bf16(y0.z, y0.w); q0[64 * j] = w;
            w.x = cvt_pk_bf16(y1.x, y1.y); w.y = cvt_pk_bf16(y1.z, y1.w); q1[64 * j] = w; }
        if (W8) { ((unsigned*)p0)[lane + 64 * j] = pk4_fp8(y0.x, y0.y, y0.z, y0.w); ((unsigned*)p1)[lane + 64 * j] = pk4_fp8(y1.x, y1.y, y1.z, y1.w); } }
}

namespace att {
constexpr float ATT_THR = 8.0f;
constexpr int KV_STAGE = 32768;
__device__ __forceinline__ unsigned off_b(unsigned row, unsigned ch) { return 256u * row + 16u * (ch ^ (((row & 3u) << 2) | ((row >> 2) & 3u))); }
__device__ __forceinline__ float half_swap_max(float m) { auto rr = __builtin_amdgcn_permlane32_swap(__float_as_uint(m), __float_as_uint(m), false, false); return fmaxf(__uint_as_float(rr[0]), __uint_as_float(rr[1])); }
__device__ __forceinline__ float half_swap_sum(float m) { auto rr = __builtin_amdgcn_permlane32_swap(__float_as_uint(m), __float_as_uint(m), false, false); return __uint_as_float(rr[0]) + __uint_as_float(rr[1]); }
__device__ __forceinline__ s16x4 vtr(const LAS unsigned char* p) { typedef short v4i16_t __attribute__((ext_vector_type(4))); return __builtin_bit_cast(s16x4, __builtin_amdgcn_ds_read_tr16_b64_v4i16((LAS v4i16_t*)p)); }
__device__ __forceinline__ bf16x8 pack8(const f32x16& p, int b) {
    u32x4 w; w.x = cvt_pk_bf16(p[b], p[b + 1]); w.y = cvt_pk_bf16(p[b + 2], p[b + 3]); w.z = cvt_pk_bf16(p[b + 4], p[b + 5]); w.w = cvt_pk_bf16(p[b + 6], p[b + 7]); return __builtin_bit_cast(bf16x8, w);
}

template <int DQK, bool DIFF, bool OUT8 = false>
__device__ __forceinline__ void attn_unit(LAS unsigned char* lds, const LAS float* tab, const int lo, bf16_t* proj, const int b, const int colK, const int colV, const int colQ, const int kch0,
                                          const int q0s, const int t0, const int t1, const int a0, const int a1, bf16_t* outp, const int ldo, const int colO, const float lam) {
    constexpr int NS = DQK / 16;
    const int tid = threadIdx.x, lane = tid & 63, wid = __builtin_amdgcn_readfirstlane(tid >> 6), r32 = lane & 31, hi = lane >> 5;
    const size_t rowb = (size_t)b * SEQ;
    bf16x8 qf[NS];
    { const bf16_t* qp = proj + (rowb + q0s + r32) * NPROJ + colQ + hi * 8;
#pragma unroll
      for (int s = 0; s < NS; ++s) qf[s] = *(const bf16x8*)(qp + s * 16); }
    unsigned kaddr[NS];
    { const unsigned xv = ((r32 & 3u) << 2) | ((r32 >> 2) & 3u);
#pragma unroll
      for (int s = 0; s < NS; ++s) kaddr[s] = 256u * r32 + 16u * (((unsigned)(kch0 + 2 * s + hi)) ^ xv); }
    unsigned vaddr[2][4];
    { const unsigned q = (lane & 15) >> 2, p = lane & 3, blk = (lane >> 4) & 1;
#pragma unroll
      for (int t2 = 0; t2 < 2; ++t2)
#pragma unroll
          for (int c = 0; c < 4; ++c) vaddr[t2][c] = 256u * (4u * hi + q) + 16u * ((((unsigned)c ^ q) << 2) | ((2u * blk + (p >> 1)) ^ ((2u * t2 + hi) & 3u))) + 8u * (p & 1u); }
    float m = 0.f, l = 0.f; bool first = true;
    f32x16 o[4];
#pragma unroll
    for (int c = 0; c < 4; ++c)
#pragma unroll
        for (int r = 0; r < 16; ++r) o[c][r] = 0.f;
    const int lr = tid >> 3, lc = (tid & 7) * 2;
    const bf16_t* kg = proj + (rowb + lr) * NPROJ + colK + lc * 8;
    const bf16_t* vg = proj + (rowb + lr) * NPROJ + colV + lc * 8;
    const unsigned wo0 = (unsigned)(lr >> 5) * 8192u + off_b(lr & 31, lc), wo1 = (unsigned)(lr >> 5) * 8192u + off_b(lr & 31, lc + 1);
    u32x4 rk0, rk1, rv0, rv1;
#define ATT_LOAD(t) do { const size_t o_ = (size_t)(t) * 64 * NPROJ; rk0 = *(const u32x4*)(kg + o_); rk1 = *(const u32x4*)(kg + o_ + 8); rv0 = *(const u32x4*)(vg + o_); rv1 = *(const u32x4*)(vg + o_ + 8); } while (0)
#define ATT_STORE(st) do { LAS unsigned char* d_ = lds + (st) * KV_STAGE; *(LAS u32x4*)(d_ + wo0) = rk0; *(LAS u32x4*)(d_ + wo1) = rk1; *(LAS u32x4*)(d_ + 16384 + wo0) = rv0; *(LAS u32x4*)(d_ + 16384 + wo1) = rv1; } while (0)
    ATT_LOAD(t0); ATT_STORE(0);
    __syncthreads();
    int st = 0;
    for (int t = t0; t < t1; ++t) {
        const int stn = (st == 2) ? 0 : st + 1;
        if (t + 1 < t1) ATT_LOAD(t + 1);
        if (t >= a0 && t < a1) {
            const LAS unsigned char* Kb = lds + st * KV_STAGE; const LAS unsigned char* Vb = Kb + 16384;
            f32x16 s0, s1;
            if (t * 64 + 63 - q0s <= lo) { const float cb = tab[0] - m;
#pragma unroll
                for (int r = 0; r < 16; ++r) { s0[r] = cb; s1[r] = cb; } }
            else if (t * 64 - (q0s + 31) - lo >= 0) {
                const LAS float* tb = tab + (t * 64 - (q0s + r32) - lo + 4 * hi);
#pragma unroll
                for (int r = 0; r < 16; ++r) { const int cr = (r & 3) + 8 * (r >> 2); s0[r] = tb[cr] - m; s1[r] = tb[32 + cr] - m; } }
            else { const int base = t * 64 - (q0s + r32) - lo + 4 * hi;
#pragma unroll
                for (int r = 0; r < 16; ++r) { const int cr = (r & 3) + 8 * (r >> 2); const int i0 = base + cr, i1 = base + 32 + cr; s0[r] = tab[i0 > 0 ? i0 : 0] - m; s1[r] = tab[i1 > 0 ? i1 : 0] - m; } }
#pragma unroll
            for (int s = 0; s < NS; ++s) { const bf16x8 k0 = *(const LAS bf16x8*)(Kb + kaddr[s]), k1 = *(const LAS bf16x8*)(Kb + 8192 + kaddr[s]);
                s0 = __builtin_amdgcn_mfma_f32_32x32x16_bf16(k0, qf[s], s0, 0, 0, 0); s1 = __builtin_amdgcn_mfma_f32_32x32x16_bf16(k1, qf[s], s1, 0, 0, 0); }
#define ATT_MX3(a_, b_, c_) __builtin_fmaxf(__builtin_fmaxf((a_), (b_)), (c_))
            float mxa = ATT_MX3(s0[0], s0[1], s1[0]), mxb = ATT_MX3(s0[2], s0[3], s1[1]); mxa = ATT_MX3(mxa, s1[2], s1[3]);
#pragma unroll
            for (int r = 4; r < 16; r += 4) { mxa = ATT_MX3(mxa, s0[r], s0[r + 1]); mxb = ATT_MX3(mxb, s0[r + 2], s0[r + 3]); mxa = ATT_MX3(mxa, s1[r], s1[r + 1]); mxb = ATT_MX3(mxb, s1[r + 2], s1[r + 3]); }
#undef ATT_MX3
            const float mx = half_swap_max(fmaxf(mxa, mxb));
            if (first || __any(mx > ATT_THR)) {
                const float dl = first ? mx : fmaxf(mx, 0.f), f = first ? 1.0f : __builtin_amdgcn_exp2f(-dl);
                m += dl; l *= f; first = false;
#pragma unroll
                for (int r = 0; r < 16; ++r) { s0[r] -= dl; s1[r] -= dl; }
#pragma unroll
                for (int c = 0; c < 4; ++c)
#pragma unroll
                    for (int r = 0; r < 16; ++r) o[c][r] *= f; }
            float rs = 0.f;
#pragma unroll
            for (int r = 0; r < 16; ++r) { s0[r] = __builtin_amdgcn_exp2f(s0[r]); s1[r] = __builtin_amdgcn_exp2f(s1[r]); rs += s0[r] + s1[r]; }
            l += rs;
            const bf16x8 pa00 = pack8(s0, 0), pa01 = pack8(s0, 8), pa10 = pack8(s1, 0), pa11 = pack8(s1, 8);
#pragma unroll
            for (int kh = 0; kh < 2; ++kh)
#pragma unroll
                for (int s2 = 0; s2 < 2; ++s2) { const bf16x8 pa = kh == 0 ? (s2 == 0 ? pa00 : pa01) : (s2 == 0 ? pa10 : pa11);
#pragma unroll
                    for (int c = 0; c < 4; ++c) { const s16x4 v0 = vtr(Vb + kh * 8192 + 256 * (16 * s2) + vaddr[0][c]), v1 = vtr(Vb + kh * 8192 + 256 * (16 * s2 + 8) + vaddr[1][c]);
                        const bf16x8 vf = (bf16x8){v0[0], v0[1], v0[2], v0[3], v1[0], v1[1], v1[2], v1[3]};
                        o[c] = __builtin_amdgcn_mfma_f32_32x32x16_bf16(vf, pa, o[c], 0, 0, 0); } }
        }
        if (t + 1 < t1) ATT_STORE(stn);
        __syncthreads();
        st = stn;
    }
#undef ATT_LOAD
#undef ATT_STORE
    const float inv = 1.0f / half_swap_sum(l);
    bf16_t* orow = outp + (rowb + q0s + r32) * (size_t)ldo + colO + 4 * hi;
    if constexpr (DIFF) {
        LAS float* xch = (LAS float*)lds + (size_t)(wid >> 1) * 4096 + lane;
        if (wid & 1) {
#pragma unroll
            for (int c = 0; c < 4; ++c)
#pragma unroll
                for (int r = 0; r < 16; ++r) xch[(c * 16 + r) * 64] = o[c][r] * inv; }
        __syncthreads();
        if (!(wid & 1)) { float ss = 0.f;
#pragma unroll
            for (int c = 0; c < 4; ++c)
#pragma unroll
                for (int r = 0; r < 16; ++r) { const float d = o[c][r] * inv - lam * xch[(c * 16 + r) * 64]; o[c][r] = d; ss += d * d; }
            ss = half_swap_sum(ss);
            const float rn = (1.0f - LAM_INIT) / sqrtf(ss * (1.0f / 128.0f) + 1e-5f);
#pragma unroll
            for (int c = 0; c < 4; ++c)
#pragma unroll
                for (int g = 0; g < 4; ++g) {
                    if constexpr (OUT8) { unsigned char* orow8 = (unsigned char*)outp + (rowb + q0s + r32) * (size_t)ldo + colO + 4 * hi; const float r8 = rn * YA_SCALE;
                        *(unsigned*)(orow8 + 32 * c + 8 * g) = pk4_fp8(o[c][4 * g] * r8, o[c][4 * g + 1] * r8, o[c][4 * g + 2] * r8, o[c][4 * g + 3] * r8); }
                    else { u32x2 w; w.x = cvt_pk_bf16(o[c][4 * g] * rn, o[c][4 * g + 1] * rn); w.y = cvt_pk_bf16(o[c][4 * g + 2] * rn, o[c][4 * g + 3] * rn); *(u32x2*)(orow + 32 * c + 8 * g) = w; } } }
        __syncthreads();
    } else if constexpr (OUT8) {
        unsigned char* orow8 = (unsigned char*)outp + (rowb + q0s + r32) * (size_t)ldo + colO + 4 * hi; const float sc8 = inv * YB_SCALE;
#pragma unroll
        for (int c = 0; c < 4; ++c)
#pragma unroll
            for (int g = 0; g < 4; ++g) *(unsigned*)(orow8 + 32 * c + 8 * g) = pk4_fp8(o[c][4 * g] * sc8, o[c][4 * g + 1] * sc8, o[c][4 * g + 2] * sc8, o[c][4 * g + 3] * sc8);
    } else {
#pragma unroll
        for (int c = 0; c < 4; ++c)
#pragma unroll
            for (int g = 0; g < 4; ++g) { u32x2 w; w.x = cvt_pk_bf16(o[c][4 * g] * inv, o[c][4 * g + 1] * inv); w.y = cvt_pk_bf16(o[c][4 * g + 2] * inv, o[c][4 * g + 3] * inv); *(u32x2*)(orow + 32 * c + 8 * g) = w; }
    }
}
__device__ __forceinline__ int t5_bucket(int rel) {
    const int n = rel < 0 ? -rel : rel;
    const int large = 8 + (n >= 12) + (n >= 16) + (n >= 23) + (n >= 32) + (n >= 46) + (n >= 64) + (n >= 91);
    return (rel > 0 ? 16 : 0) + (n < 8 ? n : large);
}
}

__device__ __forceinline__ void p4_attention(const Args& a, LAS unsigned char* lds, int G, bf16_t* outA, bf16_t* outB, int ldo, int colOA, int colOB) {
    bf16_t* proj = (bf16_t*)(a.ws + WS_PROJ);
    LAS float* tab = (LAS float*)(lds + TAB_OFF);
    const int tid = threadIdx.x, wid = __builtin_amdgcn_readfirstlane(tid >> 6);
    float lam;
    { float s01 = 0.f, s23 = 0.f;
      for (int i = 0; i < 64; ++i) { s01 += a.lambda_qk[i] * a.lambda_qk[64 + i]; s23 += a.lambda_qk[128 + i] * a.lambda_qk[192 + i]; }
      lam = expf(s01) - expf(s23) + LAM_INIT; }
    for (int it = blockIdx.x; it < NB * 8 * 8; it += G) {
        const int bh = it >> 3, j = it & 7, b = bh >> 3, h = bh & 7;
        __syncthreads();
        if (tid < 155) tab[tid] = a.t5_bias[att::t5_bucket(tid - 91) * 8 + h] * LOG2E;
        for (int half = 0; half < 2; ++half) {
            const int p = half ? 15 - j : j;
            const int map = wid & 1, qsub = wid >> 1, qc = 2 * p + (qsub >> 1);
            __syncthreads();
            att::attn_unit<64, true, true>(lds, tab, -91, proj, b, C_KA + h * 128, C_VA + h * 128, C_QA + h * 128 + map * 64, map * 8, 128 * p + 32 * qsub, 0, 2 * p + 2, 0, qc + 1, (bf16_t*)(a.ws + WS_YA8), 1024, h * 128, lam);
        }
    }
    for (int it = blockIdx.x; it < NB * 8 * 8; it += G) {
        const int bh = it >> 3, g = it & 7, b = bh >> 3, h = bh & 7;
        __syncthreads();
        if (tid < 320) { tab[tid] = a.rel_bias[(size_t)(tid  ) * 8 + h] * LOG2E; }
        const int n = 4 * g + (wid >> 1);
        const int t0 = 4 * g - 8 > 0 ? 4 * g - 8 : 0, a0 = n - 8 > 0 ? n - 8 : 0;
        __syncthreads();
        att::attn_unit<128, false, true>(lds, tab, -256, proj, b, C_KB + h * 128, C_VB + h * 128, C_QB + h * 128, 0, 64 * n + 32 * (wid & 1), t0, 4 * g + 4, a0, n + 1, (bf16_t*)(a.ws + WS_YB8), 1024, h * 128, 0.f);
    }
}

template <int CTRL> __device__ __forceinline__ float p7_dpp(float v) { return __int_as_float(__builtin_amdgcn_update_dpp(0, __float_as_int(v), CTRL, 0xf, 0xf, false)); }
__device__ __forceinline__ float p7_grp8_max(float v) {
    v = fmaxf(v, p7_dpp<0xB1>(v)); v = fmaxf(v, p7_dpp<0x4E>(v)); v = fmaxf(v, p7_dpp<0x141>(v)); return v; }
__device__ __forceinline__ float p7_wave_max(float v) {
    v = p7_grp8_max(v); v = fmaxf(v, p7_dpp<0x140>(v));
    const float r0 = __int_as_float(__builtin_amdgcn_readlane(__float_as_int(v), 0)), r1 = __int_as_float(__builtin_amdgcn_readlane(__float_as_int(v), 16));
    const float r2 = __int_as_float(__builtin_amdgcn_readlane(__float_as_int(v), 32)), r3 = __int_as_float(__builtin_amdgcn_readlane(__float_as_int(v), 48));
    return fmaxf(fmaxf(r0, r1), fmaxf(r2, r3)); }
__device__ __forceinline__ void p7_norm_route(const Args& a, LAS unsigned char* lds, int G) {
    const int tid = threadIdx.x, lane = tid & 63, wid = __builtin_amdgcn_readfirstlane(tid >> 6);
    const float* mod = (const float*)(a.ws + WS_MOD);
    bf16_t* V = (bf16_t*)(a.ws + WS_UV); const bf16_t* WrT = (const bf16_t*)(a.ws + WS_WRT);
    unsigned* ctl = (unsigned*)(a.ws + WS_CTL);
    int* selpk = (int*)(a.ws + WS_SELPK); float* selw = (float*)(a.ws + WS_SELW); int* tokof = (int*)(a.ws + WS_TOK);
    LAS float* S1 = (LAS float*)lds; LAS float* S2 = (LAS float*)(lds + 16640); LAS unsigned* lcnt = (LAS unsigned*)(lds + 33280); LAS unsigned* gbase = (LAS unsigned*)(lds + 33536);
    for (int blk = blockIdx.x; blk < T / 64; blk += G) {
        const int r0 = blk * 64, b = r0 >> 11;
        __syncthreads();
        if (tid < 64) lcnt[tid] = 0u;
        {
            const bf16_t* hb = (const bf16_t*)(a.ws + WS_H1) + (size_t)(r0 + 8 * wid) * DM;
            const float* gq = a.g_moe; const float* scq = mod + (size_t)b * NMOD + 4 * DM; const float* shq = mod + (size_t)b * NMOD + 3 * DM;
            u32x2 cur[2][8], nxt[2][8];
#pragma unroll
            for (int r = 0; r < 2; ++r)
#pragma unroll
                for (int j = 0; j < 8; ++j) cur[r][j] = ((const u32x2*)(hb + (size_t)r * DM) + lane)[64 * j];
            f32x4 mm[8], hv[8];
#pragma unroll
            for (int j = 0; j < 8; ++j) { const f32x4 gg = ((const f32x4*)gq)[lane + 64 * j], ss = ((const f32x4*)scq)[lane + 64 * j]; hv[j] = ((const f32x4*)shq)[lane + 64 * j]; mm[j] = gg * (ss + 1.0f); }
#pragma unroll
            for (int i = 0; i < 8; i += 2) {
                if (i + 2 < 8) {
#pragma unroll
                    for (int r = 0; r < 2; ++r)
#pragma unroll
                        for (int j = 0; j < 8; ++j) nxt[r][j] = ((const u32x2*)(hb + (size_t)(i + 2 + r) * DM) + lane)[64 * j]; }
                __builtin_amdgcn_sched_barrier(0);
                float s0 = 0.f, s1 = 0.f;
#pragma unroll
                for (int j = 0; j < 8; ++j) { const float a0 = bf_lo(cur[0][j].x), a1 = bf_hi(cur[0][j].x), a2 = bf_lo(cur[0][j].y), a3 = bf_hi(cur[0][j].y); s0 += (a0 * a0 + a1 * a1) + (a2 * a2 + a3 * a3);
                    const float c0 = bf_lo(cur[1][j].x), c1 = bf_hi(cur[1][j].x), c2 = bf_lo(cur[1][j].y), c3 = bf_hi(cur[1][j].y); s1 += (c0 * c0 + c1 * c1) + (c2 * c2 + c3 * c3); }
#pragma unroll
                for (int o = 1; o < 64; o <<= 1) { s0 += __shfl_xor(s0, o); s1 += __shfl_xor(s1, o); }
                const float rn0 = 1.0f / sqrtf(s0 * (1.0f / DM) + 1e-6f), rn1 = 1.0f / sqrtf(s1 * (1.0f / DM) + 1e-6f);
                const int row = r0 + 8 * wid + i;
                u32x2* q0 = (u32x2*)(V + (size_t)row * DM) + lane; u32x2* q1 = (u32x2*)(V + (size_t)(row + 1) * DM) + lane;
                unsigned* p0 = (unsigned*)(a.ws + WS_V8 + (size_t)row * DM) + lane; unsigned* p1 = (unsigned*)(a.ws + WS_V8 + (size_t)(row + 1) * DM) + lane;
#pragma unroll
                for (int j = 0; j < 8; ++j) { const f32x4 x0 = (f32x4){bf_lo(cur[0][j].x), bf_hi(cur[0][j].x), bf_lo(cur[0][j].y), bf_hi(cur[0][j].y)}, x1 = (f32x4){bf_lo(cur[1][j].x), bf_hi(cur[1][j].x), bf_lo(cur[1][j].y), bf_hi(cur[1][j].y)};
                    const f32x4 y0 = x0 * rn0 * mm[j] + hv[j], y1 = x1 * rn1 * mm[j] + hv[j];
                    u32x2 w; w.x = cvt_pk_bf16(y0.x, y0.y); w.y = cvt_pk_bf16(y0.z, y0.w); q0[64 * j] = w; w.x = cvt_pk_bf16(y1.x, y1.y); w.y = cvt_pk_bf16(y1.z, y1.w); q1[64 * j] = w;
                    p0[64 * j] = pk4_fp8(y0.x, y0.y, y0.z, y0.w); p1[64 * j] = pk4_fp8(y1.x, y1.y, y1.z, y1.w); }
                if (i + 2 < 8) {
#pragma unroll
                    for (int r = 0; r < 2; ++r)
#pragma unroll
                        for (int j = 0; j < 8; ++j) cur[r][j] = nxt[r][j]; }
            }
        }
        VM_WAIT(); __syncthreads();
        {
            constexpr int RP = 528; unsigned stg_ = 34816u; asm volatile("" : "+s"(stg_));
            LAS unsigned char* LA = lds + stg_; LAS unsigned char* LB = LA + 64 * RP;
            int t2_ = threadIdx.x; asm volatile("" : "+v"(t2_));
            const int lane = t2_ & 63, wid = __builtin_amdgcn_readfirstlane(t2_ >> 6);
            const int rb = wid & 3, eh = wid >> 2, half = lane >> 5, c16 = lane & 31;
            f32x4 acc0 = (f32x4){0.f, 0.f, 0.f, 0.f}, acc1 = acc0;
            const bf16_t* gA = V + (size_t)(r0 + 8 * wid + half) * DM + 8 * c16; const bf16_t* gB = WrT + (size_t)(8 * wid + half) * DM + 8 * c16;
            const unsigned wofs = (unsigned)(8 * wid + half) * RP + 16u * c16;
            const unsigned fa = (unsigned)(16 * rb + (lane & 15)) * RP + 16u * (lane >> 4), fb = (unsigned)(32 * eh + (lane & 15)) * RP + 16u * (lane >> 4);
            u32x4 pa[4], pb[4];
#pragma unroll
            for (int i = 0; i < 4; ++i) { pa[i] = *(const u32x4*)(gA + (size_t)(2 * i) * DM); pb[i] = *(const u32x4*)(gB + (size_t)(2 * i) * DM); }
#pragma unroll 1
            for (int c = 0; c < 8; ++c) {
#pragma unroll
                for (int i = 0; i < 4; ++i) { *(LAS u32x4*)(LA + wofs + 2 * i * RP) = pa[i]; *(LAS u32x4*)(LB + wofs + 2 * i * RP) = pb[i]; }
                __syncthreads();
                if (c + 1 < 8) {
#pragma unroll
                    for (int i = 0; i < 4; ++i) { pa[i] = *(const u32x4*)(gA + (size_t)(2 * i) * DM + 256 * (c + 1)); pb[i] = *(const u32x4*)(gB + (size_t)(2 * i) * DM + 256 * (c + 1)); } }
#pragma unroll
                for (int kk = 0; kk < 8; ++kk) { const bf16x8 av = *(const LAS bf16x8*)(LA + fa + 64 * kk), b0 = *(const LAS bf16x8*)(LB + fb + 64 * kk), b1 = *(const LAS bf16x8*)(LB + fb + 16 * RP + 64 * kk);
                    acc0 = __builtin_amdgcn_mfma_f32_16x16x32_bf16(av, b0, acc0, 0, 0, 0); acc1 = __builtin_amdgcn_mfma_f32_16x16x32_bf16(av, b1, acc1, 0, 0, 0); }
                __syncthreads();
            }
#pragma unroll
            for (int r = 0; r < 4; ++r) { const int row = 16 * rb + 4 * (lane >> 4) + r; S1[row * 65 + 32 * eh + (lane & 15)] = acc0[r]; S1[row * 65 + 32 * eh + 16 + (lane & 15)] = acc1[r]; }
        }
        __syncthreads();
        LAS int* selE = (LAS int*)S2; LAS float* selW = (LAS float*)S2 + 512; LAS int* selR = (LAS int*)S2 + 1024;
        {
            const float rb = a.router_bias[lane];
            for (int i = 0; i < 8; ++i) { const int t = 8 * wid + i;
                const float sg = 1.0f / (1.0f + expf(-S1[t * 65 + lane])); const float bs = sg + rb;
                const float m1 = p7_grp8_max(bs);
                const unsigned long long eq = __ballot(bs == m1);
                const int first = __builtin_ctz(((unsigned)(eq >> (lane & 56)) & 0xffu) | 0x100u);
                const float m2 = p7_grp8_max(((lane & 7) == first) ? -1e30f : bs);
                const float gs = m1 + m2;
                bool chosen = false;
#pragma unroll
                for (int it = 0; it < 4; ++it) { const float c = chosen ? -1e30f : gs; const float b = p7_wave_max(c); const unsigned long long mm = __ballot(c == b);
                    const int gl = __builtin_amdgcn_readfirstlane((int)(__builtin_ctzll(mm | (1ull << 63)) >> 3)); chosen = chosen || ((lane >> 3) == gl); }
                float cand = chosen ? bs : -3e38f, wsum = 0.f, myW = 0.f; int myE = 0;
#pragma unroll
                for (int k = 0; k < 8; ++k) { const float b = p7_wave_max(cand); const unsigned long long mm = __ballot(cand == b);
                    const int pick = __builtin_amdgcn_readfirstlane((int)__builtin_ctzll(mm | (1ull << 63)));
                    const float wk = __int_as_float(__builtin_amdgcn_readlane(__float_as_int(sg), pick));
                    cand = (lane == pick) ? -3e38f : cand; if (lane == k) { myE = pick; myW = wk; } wsum += wk; }
                if (lane < 8) { const int lr = (int)atomicAdd((unsigned*)(lcnt + myE), 1u); selE[t * 8 + lane] = myE; selW[t * 8 + lane] = myW * (2.5f / wsum); selR[t * 8 + lane] = lr; }
            }
        }
        __syncthreads();
        if (tid < 64) { const unsigned c = lcnt[tid]; gbase[tid] = c ? __hip_atomic_fetch_add(ctl + CW_CNT + 64 * tid, c, __ATOMIC_RELAXED, __HIP_MEMORY_SCOPE_AGENT) : 0u; }
        __syncthreads();
        { const int t = tid >> 3, k = tid & 7, e = selE[tid], rank = (int)gbase[e] + selR[tid];
          tokof[(size_t)e * ECAP + rank] = r0 + t; selpk[(size_t)(r0 + t) * 8 + k] = (e << 16) | rank; selw[(size_t)(r0 + t) * 8 + k] = selW[tid]; }
    }
}

struct MoeTab { LAS int* tstart; LAS int* cnt; LAS int* nun; LAS int* ug; LAS int* upn; LAS int* ue; LAS unsigned short* rowtab; };
__device__ __forceinline__ MoeTab moe_tab(LAS unsigned char* lds) { LAS unsigned char* p = lds + TAB_OFF; MoeTab m; m.tstart = (LAS int*)p; m.cnt = (LAS int*)(p + 272); m.nun = (LAS int*)(p + 540); m.ug = (LAS int*)(p + 544); m.upn = (LAS int*)(p + 640); m.ue = (LAS int*)(p + 736); m.rowtab = (LAS unsigned short*)(p + 1024); return m; }
__device__ __forceinline__ void moe_build_tstart(const Args& a, const MoeTab& m, const int tidx) {
    const int tid = tidx; unsigned* ctl = (unsigned*)(a.ws + WS_CTL);
    __syncthreads();
    if (tid < 64) { const int c = (int)__hip_atomic_load(ctl + CW_CNT + 64 * tid, __ATOMIC_RELAXED, __HIP_MEMORY_SCOPE_AGENT); m.cnt[tid] = c;
        const int tiles = (c + 255) >> 8; int inc = tiles;
#pragma unroll
        for (int o = 1; o < 64; o <<= 1) { const int v = __shfl_up(inc, o); inc += (tid >= o) ? v : 0; }
        m.tstart[tid] = inc - tiles;
        if (tid == 63) { m.tstart[NE] = inc; m.tstart[NEX] = inc + ((T + 255) >> 8); m.cnt[NE] = T; } }
    __syncthreads();
}
template <int NPN> __device__ __forceinline__ void moe_build_units(const MoeTab& m, int G, const int tidx) {
    const int tid = tidx;
    if (tid < 24) { const int nwg = m.tstart[NEX] * NPN; const long L = (long)tid * G + blockIdx.x; int g = -1, pn = 0, e = 0;
        if (L < nwg) { int wgid = (int)L; { const int q = nwg / 8, r = nwg % 8, xcd = wgid % 8, off = wgid / 8; wgid = (xcd < r ? xcd * (q + 1) : r * (q + 1) + (xcd - r) * q) + off; }
            g = wgid / NPN; pn = wgid % NPN; for (int k = 1; k < NEX; ++k) e += (m.tstart[k] <= g) ? 1 : 0; }
        m.ug[tid] = g; m.upn[tid] = pn; m.ue[tid] = e; }
    __syncthreads();
    if (tid == 0) { int n = 0; while (n < 24 && m.ug[n] >= 0) ++n; m.nun[0] = n; }
    __syncthreads();
}
struct MoeOrder8 {
    static constexpr bool GATHER = true;
    MoeTab m; const char* A; const char* B; int nun;
    __device__ __forceinline__ bool next(int i, pg8::Unit& u) const { if (i >= nun) return false; u.pm = m.ug[i]; u.pn = m.upn[i]; u.A = A; u.B = B + ((size_t)m.ue[i] * 1024 + (size_t)u.pn * 256) * DM; u.slot = i; return true; }
    __device__ __forceinline__ unsigned row(const pg8::Unit& u, int r) const { return (unsigned)m.rowtab[u.slot * 256 + r]; }
};
struct MoeOrder9 {
    static constexpr bool GATHER = true;
    MoeTab m; const char* A; const char* B; int nun;
    __device__ __forceinline__ bool next(int i, pg8::Unit& u) const { if (i >= nun) return false; u.pm = m.ug[i]; u.pn = m.upn[i]; u.A = A; u.B = B + ((size_t)m.ue[i] * DM + (size_t)u.pn * 256) * DE; u.slot = i; return true; }
    __device__ __forceinline__ unsigned row(const pg8::Unit& u, int r) const { return (unsigned)(u.pm * 256 + r); }
};

__device__ __forceinline__ void p10_combine(const Args& a, LAS unsigned char* lds, int wave, int lane, int G) {
    const MoeTab m = moe_tab(lds);
    moe_build_tstart(a, m, wave * 64 + lane);
    const float* mod = (const float*)(a.ws + WS_MOD); const unsigned char* ys = a.ws + WS_YS;
    const int* selpk = (const int*)(a.ws + WS_SELPK); const float* selw = (const float*)(a.ws + WS_SELW);
    const int gw = blockIdx.x * NWAVES + wave, NGW = G * NWAVES;
    for (int row = 2 * gw; row < T; row += 2 * NGW) {
        const int b = row >> 11;
        size_t pos[2][9]; float w[2][9];
#pragma unroll
        for (int r = 0; r < 2; ++r) {
#pragma unroll
            for (int k = 0; k < 8; ++k) { const int pk = selpk[(size_t)(row + r) * 8 + k]; pos[r][k] = ((size_t)m.tstart[pk >> 16] * 256 + (pk & 0xffff)) * DM; w[r][k] = selw[(size_t)(row + r) * 8 + k]; }
            pos[r][8] = ((size_t)m.tstart[NE] * 256 + row + r) * DM; w[r][8] = 1.0f; }
        float ss[2] = {0.f, 0.f}; f32x4 h2[2][4][2];
        float* hrow = a.out + (size_t)row * DM; const bf16_t* h1row = (const bf16_t*)(a.ws + WS_H1) + (size_t)row * DM; const float* gt = mod + (size_t)b * NMOD + 5 * DM;
#pragma unroll
        for (int j = 0; j < 4; ++j) { const int col = 8 * lane + 512 * j;
            const f32x4 g0 = *(const f32x4*)(gt + col), g1 = *(const f32x4*)(gt + col + 4);
#pragma unroll
            for (int r = 0; r < 2; ++r) { float acc[8];
#pragma unroll
                for (int q = 0; q < 8; ++q) acc[q] = 0.f;
#pragma unroll
                for (int k = 0; k < 9; ++k) { const u32x2 y = __builtin_nontemporal_load((const u32x2*)(ys + pos[r][k] + col));
                    const f32x2 y0 = __builtin_amdgcn_cvt_pk_f32_fp8((int)y.x, false), y1 = __builtin_amdgcn_cvt_pk_f32_fp8((int)y.x, true), y2 = __builtin_amdgcn_cvt_pk_f32_fp8((int)y.y, false), y3 = __builtin_amdgcn_cvt_pk_f32_fp8((int)y.y, true);
                    const float wk = w[r][k];
                    acc[0] += wk * y0.x; acc[1] += wk * y0.y; acc[2] += wk * y1.x; acc[3] += wk * y1.y; acc[4] += wk * y2.x; acc[5] += wk * y2.y; acc[6] += wk * y3.x; acc[7] += wk * y3.y; }
                const u32x4 xb = __builtin_nontemporal_load((const u32x4*)(h1row + (size_t)r * DM + col)); const f32x4 x0 = (f32x4){bf_lo(xb.x), bf_hi(xb.x), bf_lo(xb.y), bf_hi(xb.y)}, x1 = (f32x4){bf_lo(xb.z), bf_hi(xb.z), bf_lo(xb.w), bf_hi(xb.w)};
#pragma unroll
                for (int q = 0; q < 4; ++q) { h2[r][j][0][q] = x0[q] + g0[q] * acc[q]; h2[r][j][1][q] = x1[q] + g1[q] * acc[4 + q]; ss[r] += h2[r][j][0][q] * h2[r][j][0][q] + h2[r][j][1][q] * h2[r][j][1][q]; } }
            __builtin_amdgcn_sched_barrier(0); }
#pragma unroll
        for (int o = 1; o < 64; o <<= 1) { ss[0] += __shfl_xor(ss[0], o); ss[1] += __shfl_xor(ss[1], o); }
        const float rs0 = 1.0f / sqrtf(ss[0] * (1.0f / DM) + 1e-6f), rs1 = 1.0f / sqrtf(ss[1] * (1.0f / DM) + 1e-6f);
#pragma unroll
        for (int j = 0; j < 4; ++j) { const int col = 8 * lane + 512 * j; const f32x4 g0 = *(const f32x4*)(a.g_final + col), g1 = *(const f32x4*)(a.g_final + col + 4);
            *(f32x4*)(hrow + col) = h2[0][j][0] * rs0 * g0; *(f32x4*)(hrow + col + 4) = h2[0][j][1] * rs0 * g1;
            *(f32x4*)(hrow + DM + col) = h2[1][j][0] * rs1 * g0; *(f32x4*)(hrow + DM + col + 4) = h2[1][j][1] * rs1 * g1; }
    }
}

__device__ __forceinline__ void ph2_norm1(const Args& args, int wave, int lane, int G) {
    unsigned char* ws = args.ws; const float* mod = (const float*)(ws + WS_MOD); bf16_t* U = (bf16_t*)(ws + WS_UV);
    const int gw = blockIdx.x * NWAVES + wave, NGW = G * NWAVES;
    for (int m = 2 * gw; m < T; m += 2 * NGW) { const int b = m >> 11; norm_rows2_mod_bf16<true, false, false>(args.x + (size_t)m * DM, args.x + (size_t)(m + 1) * DM, args.g_attn, mod + (size_t)b * NMOD + DM, mod + (size_t)b * NMOD, U + (size_t)m * DM, U + (size_t)(m + 1) * DM, lane, ws + WS_U8 + (size_t)m * DM, ws + WS_U8 + (size_t)(m + 1) * DM); }
}
__device__ __forceinline__ void ph3_proj(const Args& args, LAS unsigned char* lds, int G) {
    unsigned char* ws = args.ws;
    {
      pg8::StaticOrderG S; S.init(T, 6144, G, (int)blockIdx.x, ws + WS_U8, DM / 2, ws + WS_WIN, DM / 2);
      pg8::EpiProjB<false> E{(bf16_t*)(ws + WS_PROJ), 1.0f / WINB_SCALE};
      pg8::gemm_phase<pg8::EpiProjB<false>, pg8::StaticOrderG, true, true>(lds, DM / 2, DM / 2, DM / 2, S, E, (int)threadIdx.x); }
    __syncthreads();
    {
      pg8::StaticOrderG S; S.init(T, 4096, G, (int)blockIdx.x, ws + WS_U8, DM / 2, ws + WS_WIN + (size_t)6144 * DM, DM / 2);
      pg8::EpiProjB<true> E{(bf16_t*)(ws + WS_PROJ), 1.0f / WINB_SCALE};
      pg8::gemm_phase<pg8::EpiProjB<true>, pg8::StaticOrderG, true, true>(lds, DM / 2, DM / 2, DM / 2, S, E, (int)threadIdx.x); }
}
__device__ __forceinline__ void ph5_gates(const Args& args, LAS unsigned char* lds, int G) {
    unsigned char* ws = args.ws;
    const bf16_t* proj = (const bf16_t*)(ws + WS_PROJ);
    static_assert(WUA_SCALE * YA_SCALE == WUB_SCALE * YB_SCALE, "both halves must carry the same operand scale");
    pg8::StaticOrderG S; S.init(T, DM, G, (int)blockIdx.x, ws + WS_YA8, 512, ws + WS_WUA, 512);
    pg8::EpiGate2 E{proj + C_GA, proj + C_GB, NPROJ, DM, 1.0f / (WUA_SCALE * YA_SCALE), ws + WS_M8};
    pg8::gemm_phase<pg8::EpiGate2, pg8::StaticOrderG, true, true>(lds, DM / 2, 512, 512, S, E, (int)threadIdx.x, (long)WS_YB8 - (long)WS_YA8, (long)WS_WUB - (long)WS_WUA);
}
__device__ __forceinline__ void ph6_wo(const Args& args, LAS unsigned char* lds, int G) {
    unsigned char* ws = args.ws;
    pg8::StaticOrderG S; S.init(T, DM, G, (int)blockIdx.x, ws + WS_M8, DM / 2, ws + WS_WO, DM / 2);
    pg8::EpiRes E{args.x, (const float*)(ws + WS_MOD) + 2 * DM, (bf16_t*)(ws + WS_H1), 1.0f / (WO_SCALE * MG_SCALE)};
    pg8::gemm_phase<pg8::EpiRes, pg8::StaticOrderG, true, true>(lds, DM / 2, DM / 2, DM / 2, S, E, (int)threadIdx.x);
}
__device__ __forceinline__ void ph8_gateup(const Args& args, LAS unsigned char* lds, int G, const int tidx) {
    unsigned char* ws = args.ws; const int tid = tidx;
    const MoeTab m = moe_tab(lds);
    moe_build_tstart(args, m, tidx);
    moe_build_units<4>(m, G, tidx);
    { const int* tokof = (const int*)(ws + WS_TOK); const int nun = m.nun[0];
      int tkv[6];
#pragma unroll
      for (int it = 0; it < 6; ++it) { const int q = tid + it * (NWAVES * 64); tkv[it] = 0;
          if (q < nun * 256) { const int i = q >> 8, r = q & 255, e = m.ue[i], idx = (m.ug[i] - m.tstart[e]) * 256 + r;
              tkv[it] = (e == NE) ? idx : (idx < m.cnt[e] ? tokof[(size_t)e * ECAP + idx] : 0); } }
#pragma unroll
      for (int it = 0; it < 6; ++it) { const int q = tid + it * (NWAVES * 64); if (q < nun * 256) m.rowtab[q] = (unsigned short)tkv[it]; }
      for (int q = tid + 6 * (NWAVES * 64); q < nun * 256; q += NWAVES * 64) { const int i = q >> 8, r = q & 255, e = m.ue[i], idx = (m.ug[i] - m.tstart[e]) * 256 + r;
          const int tk = (e == NE) ? idx : (idx < m.cnt[e] ? tokof[(size_t)e * ECAP + idx] : 0); m.rowtab[q] = (unsigned short)tk; } }
    __syncthreads();
    MoeOrder8 S{m, (const char*)(ws + WS_V8), (const char*)(ws + WS_WGU), __builtin_amdgcn_readfirstlane(m.nun[0])};
    pg8::EpiSwiGLU8 E{ws + WS_HB, 1.0f / WGU_SCALE};
    pg8::gemm_phase<pg8::EpiSwiGLU8, MoeOrder8, true, true>(lds, DM / 2, DM / 2, DM / 2, S, E, tidx);
}
__device__ __forceinline__ void ph9_down(const Args& args, LAS unsigned char* lds, int G, const int tidx) {
    unsigned char* ws = args.ws;
    const MoeTab m = moe_tab(lds);
    moe_build_tstart(args, m, tidx);
    moe_build_units<8>(m, G, tidx);
    MoeOrder9 S{m, (const char*)(ws + WS_HB), (const char*)(ws + WS_WD), __builtin_amdgcn_readfirstlane(m.nun[0])};
    pg8::EpiYs8 E{ws + WS_YS, 1.0f / WD_SCALE};
    pg8::gemm_phase<pg8::EpiYs8, MoeOrder9, true, true>(lds, DE / 2, DE / 2, DE / 2, S, E, tidx);
}

constexpr int NPHASES = 11;
typedef const __attribute__((address_space(4))) Args* KArgP;
__device__ __forceinline__ Args load_args() {
#if defined(__HIP_DEVICE_COMPILE__)
    KArgP kp = (KArgP)__builtin_amdgcn_kernarg_segment_ptr();
    asm volatile("" : "+s"(kp));
    const Args* gp = (const Args*)kp;
    return *gp;
#else
    return Args{};
#endif
}
__global__ void __launch_bounds__(NWAVES * 64, 2) mk_fwd(Args args_unused) {
    extern __shared__ __attribute__((aligned(16))) unsigned char lds_raw[];
    LAS unsigned char* lds = (LAS unsigned char*)lds_raw;
    volatile LAS unsigned* MISC = (volatile LAS unsigned*)(lds + MISC_OFF);
    const int G = gridDim.x;
    const int s_wave_ = __builtin_amdgcn_readfirstlane((int)threadIdx.x >> 6);
#define TIDSW() (s_wave_ * 64 + (int)asm_lane_id())
    if (threadIdx.x < 64) MISC[threadIdx.x] = 0u;
#define PH_IDS const int lane = (int)asm_lane_id(), wave = s_wave_
    __syncthreads();
    int lo, hi; unsigned* ctl;
    { const Args a0 = load_args(); lo = a0.ph_lo; hi = a0.ph_hi; ctl = (unsigned*)(a0.ws + WS_CTL); }
    XcdBarrier bar; bar.bar = ctl + CW_BAR; bar.x = 0; bar.st = nullptr;
    if (hi - lo > 1) bar = xcd_barrier_post(ctl + CW_BAR, MISC + 8);
#ifndef PH_MASK
#define PH_MASK 0x7ff
#endif
#define IN(k) (((PH_MASK >> (k)) & 1) && lo <= (k) && (k) < hi)
#define SEAM(k) do { if (IN(k) && IN((k) + 1)) xcd_barrier(bar, TIDSW()); } while (0)

    if (IN(0)) { const Args args = load_args(); PH_IDS; p0_prologue(args, lds, wave, lane, G); } SEAM(0);
    if (IN(1)) { const Args args = load_args(); p1_mod_reduce(args, G); } SEAM(1);
    if (IN(2)) { const Args args = load_args(); PH_IDS; ph2_norm1(args, wave, lane, G); } SEAM(2);
    if (IN(3)) { const Args args = load_args(); ph3_proj(args, lds, G); } SEAM(3);
    if (IN(4)) { const Args args = load_args(); bf16_t* proj = (bf16_t*)(args.ws + WS_PROJ); p4_attention(args, lds, G, proj, proj, NPROJ, C_QA, C_QB); } SEAM(4);
    if (IN(5)) { const Args args = load_args(); ph5_gates(args, lds, G); } SEAM(5);
    if (IN(6)) { const Args args = load_args(); ph6_wo(args, lds, G); } SEAM(6);
    if (IN(7)) { const Args args = load_args(); p7_norm_route(args, lds, G); } SEAM(7);
    if (IN(8)) { const Args args = load_args(); ph8_gateup(args, lds, G, TIDSW()); } SEAM(8);
    if (IN(9)) { const Args args = load_args(); ph9_down(args, lds, G, TIDSW()); } SEAM(9);
    if (IN(10)) { const Args args = load_args(); PH_IDS; p10_combine(args, lds, wave, lane, G); }
#undef IN
#undef SEAM
#undef PH_IDS
}

extern "C" void kernel_launch(void* const* d_in, const int* in_sizes, int n_in, void* d_out, int out_size, void* d_ws, size_t ws_size, hipStream_t stream) {
    static int grid = 0;
    if (grid == 0) {
        if (n_in != 22 || in_sizes[0] != T * DM || out_size != T * DM || ws_size < WS_END) { fprintf(stderr, "kernel_launch: unexpected problem (n_in %d, in0 %d, out %d, ws %zu < %zu)\n", n_in, n_in > 0 ? in_sizes[0] : -1, out_size, ws_size, (size_t)WS_END); grid = -1; return; }
        int dev = 0, cus = 0, per_cu = 0;
        if (hipGetDevice(&dev) != hipSuccess || hipDeviceGetAttribute(&cus, hipDeviceAttributeMultiprocessorCount, dev) != hipSuccess) { grid = -1; return; }
        if (hipFuncSetAttribute((const void*)mk_fwd, hipFuncAttributeMaxDynamicSharedMemorySize, LDS_BYTES) != hipSuccess) { fprintf(stderr, "kernel_launch: hipFuncSetAttribute failed\n"); grid = -1; return; }
        if (hipOccupancyMaxActiveBlocksPerMultiprocessor(&per_cu, (const void*)mk_fwd, NWAVES * 64, LDS_BYTES) != hipSuccess || per_cu < 1) { fprintf(stderr, "kernel_launch: occupancy query reports %d\n", per_cu); }
        (void)hipGetLastError();
        grid = cus;
    }
    if (grid < 0) return;
    if (hipMemsetAsync((char*)d_ws + WS_CTL, 0, CTL_ZERO_BYTES, stream) != hipSuccess) return;
    Args a{};
    a.x = (const float*)d_in[0]; a.c = (const float*)d_in[1]; a.w_ada = (const float*)d_in[2]; a.b_ada = (const float*)d_in[3]; a.g_attn = (const float*)d_in[4]; a.w_in = (const float*)d_in[5];
    a.lambda_qk = (const float*)d_in[6]; a.t5_bias = (const float*)d_in[7]; a.rel_bias = (const float*)d_in[8]; a.w_up_a = (const float*)d_in[9]; a.w_up_b = (const float*)d_in[10]; a.w_o = (const float*)d_in[11];
    a.g_moe = (const float*)d_in[12]; a.w_router = (const float*)d_in[13]; a.router_bias = (const float*)d_in[14]; a.w_exp_gate = (const float*)d_in[15]; a.w_exp_up = (const float*)d_in[16]; a.w_exp_down = (const float*)d_in[17];
    a.w_sh_gate = (const float*)d_in[18]; a.w_sh_up = (const float*)d_in[19]; a.w_sh_down = (const float*)d_in[20]; a.g_final = (const float*)d_in[21];
    a.out = (float*)d_out; a.ws = (unsigned char*)d_ws;
    constexpr int NL = MK_N_LAUNCHES;
    static_assert(NL == 1 || NL == NPHASES, "MK_N_LAUNCHES is 1 or 11");
    for (int li = 0; li < NL; ++li) {
        a.ph_lo = (NL == 1) ? 0 : li; a.ph_hi = (NL == 1) ? NPHASES : li + 1;
        hipLaunchKernelGGL(mk_fwd, dim3(grid), dim3(NWAVES * 64), LDS_BYTES, stream, a);
        const hipError_t le = hipPeekAtLastError();
        if (le != hipSuccess) { fprintf(stderr, "kernel_launch: launch %d failed: %s\n", li, hipGetErrorName(le)); break; }
    }
}
```

```cpp
#include <hip/hip_runtime.h>
#include <cstdio>
#include <cstdint>

#ifndef MK_N_LAUNCHES
#define MK_N_LAUNCHES 1
#endif

#define LAS __attribute__((address_space(3)))
#define GAS __attribute__((address_space(1)))
typedef unsigned short bf16_t;
typedef short bf16x8 __attribute__((ext_vector_type(8)));
typedef short s16x4 __attribute__((ext_vector_type(4)));
typedef float f32x2 __attribute__((ext_vector_type(2)));
typedef float f32x4 __attribute__((ext_vector_type(4)));
typedef float f32x16 __attribute__((ext_vector_type(16)));
typedef unsigned u32x2 __attribute__((ext_vector_type(2)));
typedef unsigned u32x4 __attribute__((ext_vector_type(4)));

constexpr int NB = 8, SEQ = 2048, DM = 2048, T = NB * SEQ;
constexpr int NPROJ = 10240;
constexpr int C_QA = 0, C_KA = 1024, C_VA = 2048, C_QB = 3072, C_KB = 4096, C_VB = 5120, C_GA = 6144, C_GB = 8192;
constexpr int NE = 64, NEX = 65  , DE = 512, ECAP = 16384;
constexpr int NMOD = 6 * DM;
constexpr float LOG2E = 1.4426950408889634f;
constexpr float QA_SCALE = 0.125f * LOG2E;
constexpr float QB_SCALE = 0.08838834764831845f * LOG2E;
constexpr float LAM_INIT = 0.2f;
constexpr float WGU_SCALE = 64.0f, WD_SCALE = 32.0f, WINB_SCALE = 64.0f, WUB_SCALE = 32.0f, YB_SCALE = 8.0f, WO_SCALE = 64.0f, MG_SCALE = 8.0f, WUA_SCALE = 32.0f, YA_SCALE = 8.0f;
constexpr size_t WS_WIN_B_OFF = 0;
constexpr int MAXTILES = 640;

constexpr size_t MiB = 1u << 20;
constexpr size_t WS_CTL = 0, CTL_ZERO_BYTES = 1 * MiB;
constexpr size_t WS_MOD = 1 * MiB;
constexpr size_t WS_SELPK = 2 * MiB, WS_SELW = 2 * MiB + 512 * 1024;
constexpr size_t WS_TOK = 3 * MiB;
constexpr size_t WS_WRT = 7 * MiB;
constexpr size_t WS_WD = 8 * MiB;
constexpr size_t WS_UV = 138 * MiB;
constexpr size_t WS_HB = 202 * MiB;
constexpr size_t WS_V8 = WS_HB + 96 * MiB;
constexpr size_t WS_YA8 = WS_HB;
constexpr size_t WS_YB8 = WS_HB + 80 * MiB;
constexpr size_t WS_U8 = WS_HB + 128 * MiB;
constexpr size_t WS_M8 = WS_U8;
constexpr size_t WS_R1 = 362 * MiB;
constexpr size_t WS_PART = WS_R1;
constexpr size_t WS_WIN = WS_R1 + 12 * MiB;
constexpr size_t WS_WUA = WS_WIN + 40 * MiB, WS_WUB = WS_WUA + 4 * MiB, WS_WO = WS_WUB + 4 * MiB;
constexpr size_t WS_WGU = WS_WO + 8 * MiB;
constexpr size_t WS_PROJ = WS_WGU + 260 * MiB;
constexpr size_t WS_H1 = WS_PROJ;
constexpr size_t WS_YS = WS_R1;
constexpr size_t WS_END = WS_PROJ + 320 * MiB;
static_assert(WS_YS + (size_t)MAXTILES * 256 * 2048 <= WS_WGU + 130 * MiB + 130 * MiB, "ys overlay");
constexpr int CW_TMO = 0, CW_CODE = 1;
constexpr int CW_CNT = 1024;
constexpr int CW_BAR = 8192;

constexpr int RING_BYTES = 131072;
constexpr int MISC_OFF = 133120;
constexpr int TAB_OFF = MISC_OFF + 256;
constexpr int PF_OFF = 147456;
constexpr int LDS_BYTES = 147456 + 2048;
constexpr int NWAVES = 8;

#define LDS_WAIT() asm volatile("s_waitcnt lgkmcnt(0)" ::: "memory")
__device__ __forceinline__ unsigned asm_lane_id() { unsigned l; asm volatile("v_mbcnt_lo_u32_b32 %0, -1, 0\n\tv_mbcnt_hi_u32_b32 %0, -1, %0" : "=v"(l)); return l; }
#define VM_WAIT() asm volatile("s_waitcnt vmcnt(0)" ::: "memory")

__device__ __forceinline__ unsigned cvt_pk_bf16(float lo, float hi) { unsigned r; asm volatile("v_cvt_pk_bf16_f32 %0, %1, %2" : "=v"(r) : "v"(lo), "v"(hi)); return r; }
__device__ __forceinline__ float bf_lo(unsigned w) { return __uint_as_float(w << 16); }
__device__ __forceinline__ float bf_hi(unsigned w) { return __uint_as_float(w & 0xffff0000u); }
__device__ __forceinline__ float sigmoidf_fast(float x) { return __builtin_amdgcn_rcpf(1.0f + __builtin_amdgcn_exp2f(-LOG2E * x)); }
__device__ __forceinline__ unsigned pk4_fp8(float a, float b, float c, float d) { int w = __builtin_amdgcn_cvt_pk_fp8_f32(a, b, 0, false); w = __builtin_amdgcn_cvt_pk_fp8_f32(c, d, w, true); return (unsigned)w; }
__device__ __forceinline__ float wave_sum(float v) {
#pragma unroll
    for (int o = 1; o < 64; o <<= 1) v += __shfl_xor(v, o);
    return v;
}

namespace pg8 {
constexpr int BM = 256, BK = 64, HALF = 128, HTB = HALF * BK * 2, STAGE_BYTES = 8 * HTB, NXCD = 8, WGM = 8;
__host__ __device__ __forceinline__ int lds_byte(int r, int c) { const int st = (r >> 4) * 2 + (c >> 5), rr = r & 15, cc = c & 31, ob = rr * 64 + cc * 2; return st * 1024 + (ob ^ (((ob >> 9) & 1) << 5)); }
__host__ __device__ __forceinline__ void stage_rc(int b, int& R, int& C) { const int st = b / 1024, sb = b % 1024, swz = sb ^ (((sb >> 9) & 1) << 5); R = (st >> 1) * 16 + swz / 64; C = (st & 1) * 32 + (swz % 64) / 2; }
__host__ __device__ __forceinline__ int perm32(int rho) { const int n = rho >> 4, i = rho & 15; return 8 * (i >> 2) + 4 * n + (i & 3); }

struct Unit { int pm, pn; const char* A; const char* B; int slot; };

struct StaticOrder {
    static constexpr bool GATHER = false;
    int nM, nN, nwg, G, c; const char* A; const char* B; size_t tstepA, tstepB;
    __device__ void init(int M, int N, int G_, int c_, const void* A_, int lda, const void* B_, int ldb) { nM = M / BM; nN = N / BM; nwg = nM * nN; G = G_; c = c_; A = (const char*)A_; B = (const char*)B_; tstepA = (size_t)BM * lda * 2; tstepB = (size_t)BM * ldb * 2; }
    __device__ bool next(int i, Unit& u) const {
        const long L = (long)i * G + c; if (L >= nwg) return false;
        int wgid = (int)L; { const int q = nwg / NXCD, r = nwg % NXCD, xcd = wgid % NXCD, off = wgid / NXCD; wgid = (xcd < r ? xcd * (q + 1) : r * (q + 1) + (xcd - r) * q) + off; }
        const int nig = WGM * nN, gid = wgid / nig, fm = gid * WGM, gsz = (nM - fm) < WGM ? (nM - fm) : WGM;
        u.pm = fm + ((wgid % nig) % gsz); u.pn = (wgid % nig) / gsz; u.A = A + (size_t)u.pm * tstepA; u.B = B + (size_t)u.pn * tstepB; u.slot = 0; return true;
    }
    __device__ __forceinline__ unsigned row(const Unit&, int) const { return 0u; }
};

struct StaticOrderG : StaticOrder {
    static constexpr bool GATHER = true;
    __device__ bool next(int i, Unit& u) const { if (!StaticOrder::next(i, u)) return false; u.A = A; return true; }
    __device__ __forceinline__ unsigned row(const Unit& u, int r) const { return (unsigned)(u.pm * BM + r); }
};

template <class E_, class = void> struct EpiPf { static constexpr bool v = false; };
template <class E_> struct EpiPf<E_, decltype((void)E_::L2PF)> { static constexpr bool v = E_::L2PF; };
template <class E_, class = void> struct EpiLaneAsm { static constexpr bool v = false; };
template <class E_> struct EpiLaneAsm<E_, decltype((void)E_::LANEASM)> { static constexpr bool v = E_::LANEASM; };
template <class E_, class = void> struct EpiScaled { static constexpr bool v = false; };
template <class E_> struct EpiScaled<E_, decltype((void)E_::SCALED)> { static constexpr bool v = E_::SCALED; };
template <class E_, class = void> struct EpiMid { static constexpr bool v = false; };
template <class E_> struct EpiMid<E_, decltype((void)E_::MIDHOOK)> { static constexpr bool v = E_::MIDHOOK; };
template <class Epi, class Sched, bool ALIGN_EPI, bool FP8 = false>
__device__ __forceinline__ void gemm_phase(LAS unsigned char* lds, const int K, const int lda, const int ldb, const Sched& S, const Epi& E, const int tid_in, const long dA2 = 0, const long dB2 = 0) {
    constexpr bool MID = EpiMid<Epi>::v;
    int tid_ = tid_in; asm volatile("" : "+v"(tid_));
    const int tid = tid_, wid = __builtin_amdgcn_readfirstlane(tid >> 6), lane = tid & 63, wr = wid >> 2, wc = wid & 3, fr = lane & 15, fq = lane >> 4;
    int nt = K / BK; asm volatile("" : "+s"(nt));
    int sR[2], sC[2]; unsigned vB[2];
#pragma unroll
    for (int i = 0; i < 2; ++i) { int R, C; stage_rc(tid * 16 + i * 8192, R, C); sR[i] = R; sC[i] = C;
        int r0;
        if (Epi::BMAP == 2) { const int rho = R & 31; r0 = 64 * (R >> 5) + 16 * ((rho & 15) >> 2) + 4 * (rho >> 4) + (rho & 3); }
        else r0 = (Epi::BMAP == 1) ? ((R & ~31) + perm32(R & 31)) : R;
        vB[i] = (unsigned)(r0 * ldb + C) * 2u; }
    const size_t kstep = (size_t)(BK * 2);
    const size_t hstepB = (size_t)((Epi::BMAP == 2) ? 8 : HALF) * ldb * 2;
    const unsigned ldsw = (unsigned)wid * 1024u;
    const int aoff = lds_byte(wr * 64 + fr, fq * 8), boff = lds_byte(wc * 32 + fr, fq * 8);
#ifndef PF_TILES
#define PF_TILES 4
#endif
#ifndef PG8_AUX
#define PG8_AUX 1
#endif
#define PG8_SA(b, h) (((b) * 2 + (h)) * HTB)
#define PG8_SB(b, h) ((4 + (b) * 2 + (h)) * HTB)
#define PG8_STAGE(bufoff, gbase, v0, v1) do { \
        __builtin_amdgcn_global_load_lds((const unsigned*)((const char*)(gbase) + (v0)), (LAS unsigned*)(lds + (bufoff) + ldsw), 16, 0, PG8_AUX); \
        __builtin_amdgcn_global_load_lds((const unsigned*)((const char*)(gbase) + (v1)), (LAS unsigned*)(lds + (bufoff) + ldsw + 8192), 16, 0, PG8_AUX); } while (0)
#define PG8_LDA(dst, b, h) do { _Pragma("unroll") for (int m = 0; m < 4; ++m) _Pragma("unroll") for (int k = 0; k < 2; ++k) dst[m][k] = *(const LAS bf16x8*)(lds + PG8_SA(b, h) + aoff + m * 2048 + k * 1024); } while (0)
#define PG8_LDB(dst, b, h) do { _Pragma("unroll") for (int n = 0; n < 2; ++n) _Pragma("unroll") for (int k = 0; k < 2; ++k) dst[n][k] = *(const LAS bf16x8*)(lds + PG8_SB(b, h) + boff + n * 2048 + k * 1024); } while (0)
#define PG8_MMA(ai, bj, At, Bt) do { __builtin_amdgcn_s_setprio(3); _Pragma("unroll") for (int m = 0; m < 4; ++m) _Pragma("unroll") for (int n = 0; n < 2; ++n) { \
        if constexpr (FP8) { typedef int i32x8_ __attribute__((ext_vector_type(8))); typedef int i32x4_ __attribute__((ext_vector_type(4))); \
            const i32x4_ b0_ = __builtin_bit_cast(i32x4_, Bt[n][0]), b1_ = __builtin_bit_cast(i32x4_, Bt[n][1]), a0_ = __builtin_bit_cast(i32x4_, At[m][0]), a1_ = __builtin_bit_cast(i32x4_, At[m][1]); \
            const i32x8_ bw_ = (i32x8_){b0_[0], b0_[1], b0_[2], b0_[3], b1_[0], b1_[1], b1_[2], b1_[3]}, aw_ = (i32x8_){a0_[0], a0_[1], a0_[2], a0_[3], a1_[0], a1_[1], a1_[2], a1_[3]}; \
            if constexpr (EpiScaled<Epi>::v) acc[ai][bj][m][n] = __builtin_amdgcn_mfma_scale_f32_16x16x128_f8f6f4(bw_, aw_, acc[ai][bj][m][n], 0, 0, 0, 0x7f7f7f7f, 0, 0x7f7f7f7f); \
            else acc[ai][bj][m][n] = __builtin_amdgcn_mfma_scale_f32_16x16x128_f8f6f4(bw_, aw_, acc[ai][bj][m][n], 0, 0, 0, 0, 0, 0); } \
        else { _Pragma("unroll") for (int k = 0; k < 2; ++k) acc[ai][bj][m][n] = __builtin_amdgcn_mfma_f32_16x16x32_bf16(Bt[n][k], At[m][k], acc[ai][bj][m][n], 0, 0, 0); } } \
        __builtin_amdgcn_s_setprio(0); } while (0)
#define PG8_WAIT_V(n) asm volatile("s_waitcnt vmcnt(" #n ")" ::: "memory")
#define PG8_WAIT_L(n) asm volatile("s_waitcnt lgkmcnt(" #n ")" ::: "memory")
#define PG8_BAR __builtin_amdgcn_s_barrier()
#define PG8_SCHED __builtin_amdgcn_sched_barrier(0)
    Unit cur, nxt; int ui = 0;
    if (!S.next(0, cur)) return;
    f32x4 acc[2][2][4][2];
#pragma unroll
    for (int a = 0; a < 2; ++a)
#pragma unroll
        for (int b = 0; b < 2; ++b)
#pragma unroll
            for (int m = 0; m < 4; ++m)
#pragma unroll
                for (int n = 0; n < 2; ++n) acc[a][b][m][n] = (f32x4){0.f, 0.f, 0.f, 0.f};
    bf16x8 At[4][2], B0[2][2], B1[2][2];
    unsigned c00, c01, c10, c11;
    const unsigned lda2 = (unsigned)(lda * 2), sc0 = (unsigned)sC[0] * 2u, sc1 = (unsigned)sC[1] * 2u;
    if constexpr (Sched::GATHER) { c00 = S.row(cur, sR[0]) * lda2 + sc0; c01 = S.row(cur, sR[1]) * lda2 + sc1; c10 = S.row(cur, HALF + sR[0]) * lda2 + sc0; c11 = S.row(cur, HALF + sR[1]) * lda2 + sc1; }
    else { c00 = (unsigned)sR[0] * lda2 + sc0; c01 = (unsigned)sR[1] * lda2 + sc1; c10 = (unsigned)(HALF + sR[0]) * lda2 + sc0; c11 = (unsigned)(HALF + sR[1]) * lda2 + sc1; }
    const char* cA = cur.A; const char* cB = cur.B;
    PG8_STAGE(PG8_SB(0, 0), cB, vB[0], vB[1]); PG8_STAGE(PG8_SB(0, 1), cB + hstepB, vB[0], vB[1]); PG8_STAGE(PG8_SA(0, 0), cA, c00, c01); PG8_STAGE(PG8_SA(0, 1), cA, c10, c11);
    if (wr == 1) PG8_BAR;
    PG8_WAIT_V(2); PG8_BAR;
    PG8_STAGE(PG8_SB(1, 0), cB + kstep, vB[0], vB[1]); PG8_STAGE(PG8_SA(1, 0), cA + kstep, c00, c01); PG8_STAGE(PG8_SB(1, 1), cB + hstepB + kstep, vB[0], vB[1]);
    PG8_WAIT_V(6); PG8_BAR;
    for (;;) {
        const bool has_next = S.next(ui + 1, nxt);
        const char* nA = has_next ? nxt.A : cA; const char* nB = has_next ? nxt.B : cB;
#pragma unroll 1
        for (int t = 0; t < nt; t += 2) {
            const bool last = (t == nt - 2);
            const char* a1 = cA + (size_t)(t + 1) * kstep;
            const char* a2 = last ? nA : cA + (size_t)(t + 2) * kstep; const char* b2 = last ? nB : cB + (size_t)(t + 2) * kstep;
            if constexpr (MID) { const int nh = nt >> 1; const long dA = dA2 - (long)nh * (long)kstep, dB = dB2 - (long)nh * (long)kstep;
                if (t == nh) { unsigned tm; asm volatile("v_mbcnt_lo_u32_b32 %0, -1, 0\n\tv_mbcnt_hi_u32_b32 %0, -1, %0" : "=v"(tm)); E.mid(acc, cur, wr, wc, (int)(tm & 15u), (int)(tm >> 4)); }
                a1 += (t >= nh) ? dA : 0; const bool s2 = !last && t >= nh - 2; a2 += s2 ? dA : 0; b2 += s2 ? dB : 0; }
            const char* a3 = a2 + kstep; const char* b3 = b2 + kstep;
            PG8_LDB(B0, 0, 0); PG8_LDB(B1, 0, 1); PG8_SCHED; PG8_LDA(At, 0, 0); PG8_STAGE(PG8_SA(1, 1), a1, c10, c11);
            PG8_WAIT_V(8); PG8_WAIT_L(0); PG8_BAR; PG8_MMA(0, 0, At, B0); PG8_MMA(0, 1, At, B1); PG8_BAR; PG8_SCHED;
            if constexpr (Sched::GATHER) { if (last && has_next) {
                unsigned lz_; asm volatile("v_mbcnt_lo_u32_b32 %0, -1, 0\n\tv_mbcnt_hi_u32_b32 %0, -1, %0" : "=v"(lz_));
                const int tz_ = wid * 64 + (int)lz_; int R0_, C0_, R1_, C1_; stage_rc(tz_ * 16, R0_, C0_); stage_rc(tz_ * 16 + 8192, R1_, C1_);
                c00 = S.row(nxt, R0_) * lda2 + (unsigned)C0_ * 2u; c01 = S.row(nxt, R1_) * lda2 + (unsigned)C1_ * 2u; c10 = S.row(nxt, HALF + R0_) * lda2 + (unsigned)C0_ * 2u; c11 = S.row(nxt, HALF + R1_) * lda2 + (unsigned)C1_ * 2u; } }
            PG8_LDA(At, 0, 1); PG8_STAGE(PG8_SB(0, 0), b2, vB[0], vB[1]); PG8_STAGE(PG8_SB(0, 1), b2 + hstepB, vB[0], vB[1]); PG8_STAGE(PG8_SA(0, 0), a2, c00, c01);
            PG8_WAIT_V(8); PG8_WAIT_L(0); PG8_BAR; PG8_MMA(1, 0, At, B0); PG8_MMA(1, 1, At, B1); PG8_BAR; PG8_SCHED;
            PG8_LDB(B0, 1, 0); PG8_LDB(B1, 1, 1); PG8_SCHED; PG8_LDA(At, 1, 0); PG8_STAGE(PG8_SA(0, 1), a2, c10, c11);
            PG8_WAIT_V(8); PG8_WAIT_L(0); PG8_BAR; PG8_MMA(0, 0, At, B0); PG8_MMA(0, 1, At, B1); PG8_BAR; PG8_SCHED;
            PG8_LDA(At, 1, 1); PG8_STAGE(PG8_SB(1, 0), b3, vB[0], vB[1]); PG8_STAGE(PG8_SB(1, 1), b3 + hstepB, vB[0], vB[1]); PG8_STAGE(PG8_SA(1, 0), a3, c00, c01);
            PG8_WAIT_V(8); PG8_WAIT_L(0); PG8_BAR; PG8_MMA(1, 0, At, B0); PG8_MMA(1, 1, At, B1); PG8_BAR; PG8_SCHED;
        }
        if constexpr (ALIGN_EPI) { if (wr == 0) PG8_BAR; }
        if constexpr (EpiLaneAsm<Epi>::v) { unsigned le_; asm volatile("v_mbcnt_lo_u32_b32 %0, -1, 0\n\tv_mbcnt_hi_u32_b32 %0, -1, %0" : "=v"(le_)); E(acc, cur, wr, wc, (int)(le_ & 15u), (int)(le_ >> 4)); }
        else E(acc, cur, wr, wc, fr, fq);
        if (!has_next) break;
        if constexpr (Sched::GATHER && EpiPf<Epi>::v) { {
            unsigned ln_; asm volatile("v_mbcnt_lo_u32_b32 %0, -1, 0\n\tv_mbcnt_hi_u32_b32 %0, -1, %0" : "=v"(ln_));
            const int L = (wid & 3) * 64 + (int)ln_;
            const char* pbase = (wid >= 4) ? nB : nA;
            const unsigned poff = (wid >= 4) ? (unsigned)L * (unsigned)(ldb * 2) : S.row(nxt, L) * lda2;
            LAS unsigned* dump = (LAS unsigned*)(lds + PF_OFF + wid * 256);
            if (2 < nt) __builtin_amdgcn_global_load_lds((const unsigned*)(pbase + poff), dump, 4, 2 * 128, PG8_AUX);
            if (3 < nt) __builtin_amdgcn_global_load_lds((const unsigned*)(pbase + poff), dump, 4, 3 * 128, PG8_AUX);
            if (PF_TILES > 2 && 4 < nt) __builtin_amdgcn_global_load_lds((const unsigned*)(pbase + poff), dump, 4, 4 * 128, PG8_AUX);
            if (PF_TILES > 3 && 5 < nt) __builtin_amdgcn_global_load_lds((const unsigned*)(pbase + poff), dump, 4, 5 * 128, PG8_AUX); } }
#pragma unroll
        for (int a = 0; a < 2; ++a)
#pragma unroll
            for (int b = 0; b < 2; ++b)
#pragma unroll
                for (int m = 0; m < 4; ++m)
#pragma unroll
                    for (int n = 0; n < 2; ++n) acc[a][b][m][n] = (f32x4){0.f, 0.f, 0.f, 0.f};
        cur = nxt; cA = nA; cB = nB; ++ui;
        if constexpr (ALIGN_EPI) { if (wr == 1) PG8_BAR; }
    }
    PG8_WAIT_V(0);
    if constexpr (!ALIGN_EPI) { if (wr == 0) PG8_BAR; }
    PG8_BAR;
#undef PG8_SA
#undef PG8_SB
#undef PG8_STAGE
#undef PG8_LDA
#undef PG8_LDB
#undef PG8_MMA
#undef PG8_WAIT_V
#undef PG8_WAIT_L
#undef PG8_BAR
#undef PG8_SCHED
}

__device__ __forceinline__ u32x4 lane_tr(const u32x4 w, const int sa) { u32x4 r; r.x = (unsigned)__builtin_amdgcn_ds_bpermute(sa, (int)w.x); r.y = (unsigned)__builtin_amdgcn_ds_bpermute(sa, (int)w.y); r.z = (unsigned)__builtin_amdgcn_ds_bpermute(sa, (int)w.z); r.w = (unsigned)__builtin_amdgcn_ds_bpermute(sa, (int)w.w); return r; }
__device__ __forceinline__ f32x4 lane_trf(const f32x4 v, const int sa) { return __builtin_bit_cast(f32x4, lane_tr(__builtin_bit_cast(u32x4, v), sa)); }
#define PG8_EPI_LANES int lane_ = fq * 16 + fr; asm volatile("" : "+v"(lane_));     \
    const int sa_ = (((lane_ & 3) << 4) + (lane_ >> 2)) << 2, tr_ = lane_ >> 2, tq_ = lane_ & 3
struct EpiProj {
    static constexpr int BMAP = 1;
    bf16_t* O; int pn_split, pn_add; float wscale;
    __device__ __forceinline__ void operator()(const f32x4 (&acc)[2][2][4][2], const Unit& u, int wr, int wc, int fr, int fq) const {
        PG8_EPI_LANES;
        const int pn = u.pn + (u.pn >= pn_split ? pn_add : 0);
        const int row0 = u.pm * BM + wr * 64 + tr_, col0 = pn * BM + wc * 32 + 8 * tq_, sec = pn >> 2;
        const float sc = wscale * ((sec == 0) ? QA_SCALE : ((sec == 3) ? QB_SCALE : 1.0f)); const bool sig = sec >= 6;
#pragma unroll
        for (int ai = 0; ai < 2; ++ai)
#pragma unroll
            for (int m = 0; m < 4; ++m) { bf16_t* rowp = O + (size_t)(row0 + ai * HALF + m * 16) * NPROJ + col0;
#pragma unroll
                for (int bj = 0; bj < 2; ++bj) { f32x4 v0 = acc[ai][bj][m][0], v1 = acc[ai][bj][m][1];
                    if (sig) { v0 = (f32x4){sigmoidf_fast(v0[0]), sigmoidf_fast(v0[1]), sigmoidf_fast(v0[2]), sigmoidf_fast(v0[3])}; v1 = (f32x4){sigmoidf_fast(v1[0]), sigmoidf_fast(v1[1]), sigmoidf_fast(v1[2]), sigmoidf_fast(v1[3])}; }
                    else { v0 = v0 * sc; v1 = v1 * sc; }
                    u32x4 w; w.x = cvt_pk_bf16(v0[0], v0[1]); w.y = cvt_pk_bf16(v0[2], v0[3]); w.z = cvt_pk_bf16(v1[0], v1[1]); w.w = cvt_pk_bf16(v1[2], v1[3]);
                    *(u32x4*)(rowp + bj * HALF) = lane_tr(w, sa_); } }
    }
};
template <bool SIG> struct EpiProjB {
    static constexpr int BMAP = 1;
    bf16_t* O; float wscale;
    __device__ __forceinline__ void operator()(const f32x4 (&acc)[2][2][4][2], const Unit& u, int wr, int wc, int fr, int fq) const {
        PG8_EPI_LANES;
        const int pn = u.pn + (SIG ? 24 : 0);
        const int row0 = u.pm * BM + wr * 64 + tr_, col0 = pn * BM + wc * 32 + 8 * tq_;
        const float sc = wscale * ((!SIG && u.pn < 4) ? QA_SCALE : ((!SIG && u.pn >= 12 && u.pn < 16) ? QB_SCALE : 1.0f));
#pragma unroll
        for (int ai = 0; ai < 2; ++ai)
#pragma unroll
            for (int m = 0; m < 4; ++m) { bf16_t* rowp = O + (size_t)(row0 + ai * HALF + m * 16) * NPROJ + col0;
#pragma unroll
                for (int bj = 0; bj < 2; ++bj) { f32x4 v0 = acc[ai][bj][m][0] * sc, v1 = acc[ai][bj][m][1] * sc;
                    if (SIG) { v0 = (f32x4){sigmoidf_fast(v0[0]), sigmoidf_fast(v0[1]), sigmoidf_fast(v0[2]), sigmoidf_fast(v0[3])}; v1 = (f32x4){sigmoidf_fast(v1[0]), sigmoidf_fast(v1[1]), sigmoidf_fast(v1[2]), sigmoidf_fast(v1[3])}; }
                    u32x4 w; w.x = cvt_pk_bf16(v0[0], v0[1]); w.y = cvt_pk_bf16(v0[2], v0[3]); w.z = cvt_pk_bf16(v1[0], v1[1]); w.w = cvt_pk_bf16(v1[2], v1[3]);
                    *(u32x4*)(rowp + bj * HALF) = lane_tr(w, sa_); }
                if (SIG) __builtin_amdgcn_sched_barrier(0); }
    }
};
template <bool ADD, bool OUT8 = false> struct EpiGate {
    static constexpr int BMAP = 1;
    const bf16_t* G; int ldg; bf16_t* O; int ldo; float wscale; unsigned char* O8;
    __device__ __forceinline__ void operator()(const f32x4 (&acc)[2][2][4][2], const Unit& u, int wr, int wc, int fr, int fq) const {
        PG8_EPI_LANES;
        const int row0 = u.pm * BM + wr * 64 + tr_, col0 = u.pn * BM + wc * 32 + 8 * tq_;
#pragma unroll
        for (int ai = 0; ai < 2; ++ai)
#pragma unroll
            for (int m = 0; m < 4; ++m) { const size_t r = (size_t)(row0 + ai * HALF + m * 16);
#pragma unroll
                for (int bj = 0; bj < 2; ++bj) { const f32x4 v0 = lane_trf(acc[ai][bj][m][0], sa_) * wscale, v1 = lane_trf(acc[ai][bj][m][1], sa_) * wscale;
                    const u32x4 g = *(const u32x4*)(G + r * ldg + col0 + bj * HALF);
                    float o0 = bf_lo(g.x) * v0[0], o1 = bf_hi(g.x) * v0[1], o2 = bf_lo(g.y) * v0[2], o3 = bf_hi(g.y) * v0[3];
                    float o4 = bf_lo(g.z) * v1[0], o5 = bf_hi(g.z) * v1[1], o6 = bf_lo(g.w) * v1[2], o7 = bf_hi(g.w) * v1[3];
                    bf16_t* op = O + r * ldo + col0 + bj * HALF;
                    if (ADD) { const u32x4 p = *(const u32x4*)op; o0 += bf_lo(p.x); o1 += bf_hi(p.x); o2 += bf_lo(p.y); o3 += bf_hi(p.y); o4 += bf_lo(p.z); o5 += bf_hi(p.z); o6 += bf_lo(p.w); o7 += bf_hi(p.w); }
                    if (OUT8) { u32x2 w8; w8.x = pk4_fp8(o0 * MG_SCALE, o1 * MG_SCALE, o2 * MG_SCALE, o3 * MG_SCALE); w8.y = pk4_fp8(o4 * MG_SCALE, o5 * MG_SCALE, o6 * MG_SCALE, o7 * MG_SCALE); *(u32x2*)(O8 + r * ldo + col0 + bj * HALF) = w8; }
                    else { u32x4 w; w.x = cvt_pk_bf16(o0, o1); w.y = cvt_pk_bf16(o2, o3); w.z = cvt_pk_bf16(o4, o5); w.w = cvt_pk_bf16(o6, o7);
                    *(u32x4*)op = w; } } }
    }
};
struct EpiGate2 {
    static constexpr int BMAP = 1; static constexpr bool MIDHOOK = true; static constexpr bool L2PF = true;
    const bf16_t* GA; const bf16_t* GB; int ldg; int ldo; float wscale; unsigned char* O8;
    __device__ __forceinline__ void mid(f32x4 (&acc)[2][2][4][2], const Unit& u, int wr, int wc, int fr, int fq) const {
        const int row0 = u.pm * BM + wr * 64 + fr, col0 = u.pn * BM + wc * 32 + 8 * fq;
#pragma unroll
        for (int ai = 0; ai < 2; ++ai)
#pragma unroll
            for (int m = 0; m < 4; ++m) { const size_t r = (size_t)(row0 + ai * HALF + m * 16);
#pragma unroll
                for (int bj = 0; bj < 2; ++bj) { const u32x4 a = *(const u32x4*)(GA + r * ldg + col0 + bj * HALF), b = *(const u32x4*)(GB + r * ldg + col0 + bj * HALF);
                    const f32x4 q0 = (f32x4){bf_lo(a.x) * __builtin_amdgcn_rcpf(fmaxf(bf_lo(b.x), 1e-20f)), bf_hi(a.x) * __builtin_amdgcn_rcpf(fmaxf(bf_hi(b.x), 1e-20f)), bf_lo(a.y) * __builtin_amdgcn_rcpf(fmaxf(bf_lo(b.y), 1e-20f)), bf_hi(a.y) * __builtin_amdgcn_rcpf(fmaxf(bf_hi(b.y), 1e-20f))};
                    const f32x4 q1 = (f32x4){bf_lo(a.z) * __builtin_amdgcn_rcpf(fmaxf(bf_lo(b.z), 1e-20f)), bf_hi(a.z) * __builtin_amdgcn_rcpf(fmaxf(bf_hi(b.z), 1e-20f)), bf_lo(a.w) * __builtin_amdgcn_rcpf(fmaxf(bf_lo(b.w), 1e-20f)), bf_hi(a.w) * __builtin_amdgcn_rcpf(fmaxf(bf_hi(b.w), 1e-20f))};
                    acc[ai][bj][m][0] = acc[ai][bj][m][0] * q0; acc[ai][bj][m][1] = acc[ai][bj][m][1] * q1; }
                __builtin_amdgcn_sched_barrier(0); }
    }
    __device__ __forceinline__ void operator()(const f32x4 (&acc)[2][2][4][2], const Unit& u, int wr, int wc, int fr, int fq) const {
        PG8_EPI_LANES;
        const int row0 = u.pm * BM + wr * 64 + tr_, col0 = u.pn * BM + wc * 32 + 8 * tq_;
        const float ws8 = wscale * MG_SCALE;
#pragma unroll
        for (int ai = 0; ai < 2; ++ai)
#pragma unroll
            for (int m = 0; m < 4; ++m) { const size_t r = (size_t)(row0 + ai * HALF + m * 16);
#pragma unroll
                for (int bj = 0; bj < 2; ++bj) { const f32x4 v0 = lane_trf(acc[ai][bj][m][0], sa_) * ws8, v1 = lane_trf(acc[ai][bj][m][1], sa_) * ws8;
                    const u32x4 g = *(const u32x4*)(GB + r * ldg + col0 + bj * HALF);
                    u32x2 w8; w8.x = pk4_fp8(fmaxf(bf_lo(g.x), 1e-20f) * v0[0], fmaxf(bf_hi(g.x), 1e-20f) * v0[1], fmaxf(bf_lo(g.y), 1e-20f) * v0[2], fmaxf(bf_hi(g.y), 1e-20f) * v0[3]);
                    w8.y = pk4_fp8(fmaxf(bf_lo(g.z), 1e-20f) * v1[0], fmaxf(bf_hi(g.z), 1e-20f) * v1[1], fmaxf(bf_lo(g.w), 1e-20f) * v1[2], fmaxf(bf_hi(g.w), 1e-20f) * v1[3]);
                    *(u32x2*)(O8 + r * ldo + col0 + bj * HALF) = w8; } }
    }
};
struct EpiRes {
    static constexpr int BMAP = 1;
    const float* X; const float* gt  ; bf16_t* out; float wscale;
    __device__ __forceinline__ void operator()(const f32x4 (&acc)[2][2][4][2], const Unit& u, int wr, int wc, int fr, int fq) const {
        PG8_EPI_LANES;
        const int row0 = u.pm * BM + wr * 64 + tr_, col0 = u.pn * BM + wc * 32 + 8 * tq_; const float* g = gt + (size_t)(u.pm >> 3) * NMOD;
        f32x4 gv[2][2];
#pragma unroll
        for (int bj = 0; bj < 2; ++bj)
#pragma unroll
            for (int n = 0; n < 2; ++n) gv[bj][n] = *(const f32x4*)(g + col0 + bj * HALF + n * 4);
#pragma unroll
        for (int ai = 0; ai < 2; ++ai)
#pragma unroll
            for (int m = 0; m < 4; ++m) { const size_t off = (size_t)(row0 + ai * HALF + m * 16) * DM + col0;
#pragma unroll
                for (int bj = 0; bj < 2; ++bj) { const f32x4 x0 = __builtin_nontemporal_load((const f32x4*)(X + off + bj * HALF)), x1 = __builtin_nontemporal_load((const f32x4*)(X + off + bj * HALF + 4));
                    const f32x4 h0 = x0 + gv[bj][0] * (lane_trf(acc[ai][bj][m][0], sa_) * wscale), h1 = x1 + gv[bj][1] * (lane_trf(acc[ai][bj][m][1], sa_) * wscale);
                    u32x4 w; w.x = cvt_pk_bf16(h0[0], h0[1]); w.y = cvt_pk_bf16(h0[2], h0[3]); w.z = cvt_pk_bf16(h1[0], h1[1]); w.w = cvt_pk_bf16(h1[2], h1[3]);
                    *(u32x4*)(out + off + bj * HALF) = w; } }
    }
};
struct EpiSwiGLU8 {
    static constexpr int BMAP = 1; static constexpr bool LANEASM = true;
    unsigned char* O; float wscale;
    __device__ __forceinline__ void operator()(const f32x4 (&acc)[2][2][4][2], const Unit& u, int wr, int wc, int fr, int fq) const {
        PG8_EPI_LANES;
        const int row0 = u.pm * BM + wr * 64 + tr_, col0 = u.pn * HALF + wc * 32 + 8 * tq_;
#pragma unroll
        for (int ai = 0; ai < 2; ++ai)
#pragma unroll
            for (int m = 0; m < 4; ++m) { float h[8];
#pragma unroll
                for (int n = 0; n < 2; ++n)
#pragma unroll
                    for (int j = 0; j < 4; ++j) { const float g = acc[ai][0][m][n][j] * wscale, up = acc[ai][1][m][n][j] * wscale; h[4 * n + j] = g * sigmoidf_fast(g) * up; }
                u32x2 w; w.x = pk4_fp8(h[0], h[1], h[2], h[3]); w.y = pk4_fp8(h[4], h[5], h[6], h[7]);
                u32x2 t; t.x = (unsigned)__builtin_amdgcn_ds_bpermute(sa_, (int)w.x); t.y = (unsigned)__builtin_amdgcn_ds_bpermute(sa_, (int)w.y);
                *(u32x2*)(O + (size_t)(row0 + ai * HALF + m * 16) * DE + col0) = t; }
    }
};
struct EpiYs8 {
    static constexpr int BMAP = 2; static constexpr bool L2PF = true;
    unsigned char* O; float wscale;
    __device__ __forceinline__ void operator()(const f32x4 (&acc)[2][2][4][2], const Unit& u, int wr, int wc, int fr, int fq) const {
        PG8_EPI_LANES;
        const int row0 = u.pm * BM + wr * 64 + tr_, col0 = u.pn * BM + wc * 64 + 16 * tq_;
#pragma unroll
        for (int ai = 0; ai < 2; ++ai)
#pragma unroll
            for (int m = 0; m < 4; ++m) { u32x4 w;
                { const f32x4 a = acc[ai][0][m][0] * wscale, b = acc[ai][0][m][1] * wscale, c = acc[ai][1][m][0] * wscale, d = acc[ai][1][m][1] * wscale;
                  w.x = pk4_fp8(a[0], a[1], a[2], a[3]); w.y = pk4_fp8(b[0], b[1], b[2], b[3]); w.z = pk4_fp8(c[0], c[1], c[2], c[3]); w.w = pk4_fp8(d[0], d[1], d[2], d[3]); }
                *(u32x4*)(O + (size_t)(row0 + ai * HALF + m * 16) * DM + col0) = lane_tr(w, sa_); }
    }
};
}

#define XB_TMO      128
#define XB_XCNT(j)  (256  + 64 * (j))
#define XB_XSUB(j)  (1280 + 64 * (j))
#define XB_XGEN(j)  (2304 + 64 * (j))
#define XB_TOP      3328
#define XB_TOPGEN   3392
#define XCD_BAR_WORDS 3456
#define XB_SPIN_CAP (1u << 18)
__device__ __forceinline__ unsigned xb_ld(unsigned* p)              { return __hip_atomic_load(p, __ATOMIC_RELAXED, __HIP_MEMORY_SCOPE_AGENT); }
__device__ __forceinline__ unsigned xb_add(unsigned* p, unsigned v) { return __hip_atomic_fetch_add(p, v, __ATOMIC_RELAXED, __HIP_MEMORY_SCOPE_AGENT); }
__device__ __forceinline__ unsigned xb_xcc_id() { return (unsigned)__builtin_amdgcn_s_getreg((3 << 11) | 20) & 0xFu; }
#define XB_SPIN(cond, bar) do { unsigned _sp = 0; while (cond) { __builtin_amdgcn_s_sleep(1); \
    if ((++_sp & 255u) == 0u) { if (xb_ld(&(bar)[XB_TMO])) break; if (_sp > XB_SPIN_CAP) { atomicAdd(&(bar)[XB_TMO], 1u); break; } } } } while (0)
struct XcdBarrier { unsigned* bar; unsigned x; volatile LAS unsigned* st; };
__device__ __forceinline__ XcdBarrier xcd_barrier_post(unsigned* bar, volatile LAS unsigned* st) {
    XcdBarrier b; b.bar = bar; b.x = xb_xcc_id(); b.st = st;
    if (threadIdx.x == 0) (void)xb_add(&bar[XB_XCNT(b.x)], 1u);
    return b;
}
__device__ __forceinline__ void xcd_barrier_complete(unsigned* bar, unsigned x, unsigned& nloc, unsigned& nx) {
    const unsigned G = gridDim.x * gridDim.y * gridDim.z;
    unsigned sum, cnt, mine, sp = 0u;
    for (;;) {
        sum = 0u; cnt = 0u; mine = 0u;
#pragma unroll
        for (unsigned j = 0; j < 16; ++j) { const unsigned c = xb_ld(&bar[XB_XCNT(j)]); sum += c; cnt += (c > 0u) ? 1u : 0u; mine = (j == x) ? c : mine; }
        if (sum == G) break;
        __builtin_amdgcn_s_sleep(1);
        if ((++sp & 255u) == 0u) { if (xb_ld(&bar[XB_TMO])) break; if (sp > XB_SPIN_CAP) { atomicAdd(&bar[XB_TMO], 1u); break; } }
    }
    nloc = mine > 0u ? mine : 1u; nx = cnt > 0u ? cnt : 1u;
}
__device__ __forceinline__ void xcd_barrier(const XcdBarrier& b, const int tidx) {
    asm volatile("s_waitcnt vmcnt(0)" ::: "memory");
    __syncthreads();
    if (tidx == 0) {
        unsigned* bar = b.bar;
        __builtin_amdgcn_s_waitcnt(0);
        unsigned nloc = b.st[0], nx = b.st[1];
        if (nloc == 0u) { xcd_barrier_complete(bar, b.x, nloc, nx); b.st[0] = nloc; b.st[1] = nx; }
        const unsigned old = xb_add(&bar[XB_XSUB(b.x)], 1u);
        const unsigned gen = old / nloc;
        if (old + 1u == (gen + 1u) * nloc) {
            __builtin_amdgcn_fence(__ATOMIC_RELEASE, "agent");
            asm volatile("s_waitcnt vmcnt(0)" ::: "memory");
            const unsigned og = xb_add(&bar[XB_TOP], 1u);
            const unsigned tg = og / nx;
            if (og + 1u == (tg + 1u) * nx) xb_add(&bar[XB_TOPGEN], 1u);
            else XB_SPIN(xb_ld(&bar[XB_TOPGEN]) == tg, bar);
            __builtin_amdgcn_fence(__ATOMIC_ACQUIRE, "agent");
            xb_add(&bar[XB_XGEN(b.x)], 1u);
            asm volatile("s_waitcnt vmcnt(0)" ::: "memory");
        } else {
            XB_SPIN(xb_ld(&bar[XB_XGEN(b.x)]) == gen, bar);
            __builtin_amdgcn_fence(__ATOMIC_ACQUIRE, "agent");
            asm volatile("s_waitcnt vmcnt(0)" ::: "memory");
        }
    }
    __syncthreads();
}

struct Args {
    const float* x; const float* c; const float* w_ada; const float* b_ada; const float* g_attn; const float* w_in; const float* lambda_qk; const float* t5_bias; const float* rel_bias;
    const float* w_up_a; const float* w_up_b; const float* w_o; const float* g_moe; const float* w_router; const float* router_bias; const float* w_exp_gate; const float* w_exp_up; const float* w_exp_down;
    const float* w_sh_gate; const float* w_sh_up; const float* w_sh_down; const float* g_final;
    float* out; unsigned char* ws; int ph_lo, ph_hi;
};

__device__ __forceinline__ void p0_ada_item(const Args& a, float* part, LAS float* scr, int item, int lane) {
    const int cg = item % 48, kc = item / 48, n0 = 256 * cg + 4 * lane;
#pragma unroll
    for (int b = 0; b < 8; ++b) { const float cv = a.c[b * DM + 64 * kc + lane]; scr[lane * 8 + b] = cv * sigmoidf_fast(cv); }
    LDS_WAIT(); asm volatile("" ::: "memory");
    f32x4 acc[8];
#pragma unroll
    for (int b = 0; b < 8; ++b) acc[b] = (f32x4){0.f, 0.f, 0.f, 0.f};
    const float* wp = a.w_ada + (size_t)(64 * kc) * NMOD + n0;
#pragma unroll 16
    for (int kk = 0; kk < 64; ++kk) { const f32x4 w = __builtin_nontemporal_load((const f32x4*)(wp + (size_t)kk * NMOD));
        const f32x4 s0 = *(const LAS f32x4*)(scr + kk * 8), s1 = *(const LAS f32x4*)(scr + kk * 8 + 4);
        acc[0] += w * s0[0]; acc[1] += w * s0[1]; acc[2] += w * s0[2]; acc[3] += w * s0[3]; acc[4] += w * s1[0]; acc[5] += w * s1[1]; acc[6] += w * s1[2]; acc[7] += w * s1[3]; }
#pragma unroll
    for (int b = 0; b < 8; ++b) *(f32x4*)(part + ((size_t)(kc * 8 + b) * NMOD + n0)) = acc[b];
    LDS_WAIT(); asm volatile("" ::: "memory");
}
struct P0Item { const float* W; int K, N; unsigned char* dst; int mode; float sc; int item; int row_off; };
__device__ __forceinline__ P0Item p0_decode(const Args& a, int r) {
    unsigned char* ws = a.ws; P0Item t;
    constexpr int I_IN = 32 * 160, I_UP = 16 * 32, I_O = 32 * 32, I_EG = 32 * 8, I_ED = 8 * 32;
    if (r < I_IN) {
        t = P0Item{a.w_in, DM, NPROJ, ws + WS_WIN, 0, WINB_SCALE, r, 0}; return t; } r -= I_IN;
    if (r < I_UP) { t = P0Item{a.w_up_a, 1024, DM, ws + WS_WUA, 0, WUA_SCALE, r, 0}; return t; } r -= I_UP;
    if (r < I_UP) { t = P0Item{a.w_up_b, 1024, DM, ws + WS_WUB, 0, WUB_SCALE, r, 0}; return t; } r -= I_UP;
    if (r < I_O) { t = P0Item{a.w_o, DM, DM, ws + WS_WO, 0, WO_SCALE, r, 0}; return t; } r -= I_O;
    if (r < NEX * 2 * I_EG) { const int e = r / (2 * I_EG), q = r % (2 * I_EG), up = q / I_EG;
        const float* W = (e < NE) ? ((up ? a.w_exp_up : a.w_exp_gate) + (size_t)e * DM * DE) : (up ? a.w_sh_up : a.w_sh_gate);
        t = P0Item{W, DM, DE, ws + WS_WGU + (size_t)e * 1024 * DM, up ? 2 : 1, WGU_SCALE, q % I_EG, 0}; return t; } r -= NEX * 2 * I_EG;
    if (r < NEX * I_ED) { const int e = r / I_ED; const float* W = (e < NE) ? (a.w_exp_down + (size_t)e * DE * DM) : a.w_sh_down;
        t = P0Item{W, DE, DM, ws + WS_WD + (size_t)e * DM * DE, 0, WD_SCALE, r % I_ED, 0}; return t; } r -= NEX * I_ED;
    t = P0Item{a.w_router, DM, NE, ws + WS_WRT, 0, 0.f, r, 0}; return t;
}
#define P0_LOAD(T, tv) do { const int nkb_ = (T).K / 64, k0_ = 64 * ((T).item % nkb_), n0_ = 64 * ((T).item / nkb_);     \
        const float* wp_ = (T).W + (size_t)(k0_ + (lane >> 4)) * (T).N + n0_ + 4 * (lane & 15); \
        _Pragma("unroll") for (int i_ = 0; i_ < 16; ++i_) { const float* p_ = wp_ + (size_t)(4 * i_) * (T).N; asm volatile("global_load_dwordx4 %0, %1, off nt" : "=v"(tv[i_]) : "v"(p_) : "memory"); } } while (0)
#define P0_WAIT(tv, N) asm volatile("s_waitcnt vmcnt(" #N ")" : "+v"(tv[0]), "+v"(tv[1]), "+v"(tv[2]), "+v"(tv[3]), "+v"(tv[4]), "+v"(tv[5]), "+v"(tv[6]), "+v"(tv[7]), "+v"(tv[8]), "+v"(tv[9]), "+v"(tv[10]), "+v"(tv[11]), "+v"(tv[12]), "+v"(tv[13]), "+v"(tv[14]), "+v"(tv[15]) :: "memory")
__device__ __forceinline__ void p0_emit(const P0Item& T, const f32x4 (&tv)[16], LAS float* scr, int lane) {
    const int nkb = T.K / 64, k0 = 64 * (T.item % nkb), n0 = 64 * (T.item / nkb);
#pragma unroll
    for (int i = 0; i < 16; ++i) { LAS float* d = scr + (4 * i + (lane >> 4)) * 65 + 4 * (lane & 15); d[0] = tv[i].x; d[1] = tv[i].y; d[2] = tv[i].z; d[3] = tv[i].w; }
    LDS_WAIT(); asm volatile("" ::: "memory");
    const int r0 = T.row_off + ((T.mode == 0) ? n0 : ((n0 >> 7) * 256 + (n0 & 127) + (T.mode == 2 ? 128 : 0)));
    if (T.sc == 0.f) { const int c = lane & 7;
#pragma unroll
        for (int j = 0; j < 8; ++j) { const int n = (lane >> 3) + 8 * j; const LAS float* sp = scr + (8 * c) * 65 + n;
            u32x4 o; o.x = cvt_pk_bf16(sp[0 * 65], sp[1 * 65]); o.y = cvt_pk_bf16(sp[2 * 65], sp[3 * 65]); o.z = cvt_pk_bf16(sp[4 * 65], sp[5 * 65]); o.w = cvt_pk_bf16(sp[6 * 65], sp[7 * 65]);
            *(u32x4*)((bf16_t*)T.dst + (size_t)(r0 + n) * T.K + k0 + 8 * c) = o; } }
    else { const float sc = T.sc; const int kq = lane & 3;
#pragma unroll
        for (int j = 0; j < 4; ++j) { const int n = (lane >> 2) + 16 * j; const LAS float* sp = scr + (16 * kq) * 65 + n;
            u32x4 o;
            o.x = pk4_fp8(sp[0 * 65] * sc, sp[1 * 65] * sc, sp[2 * 65] * sc, sp[3 * 65] * sc);     o.y = pk4_fp8(sp[4 * 65] * sc, sp[5 * 65] * sc, sp[6 * 65] * sc, sp[7 * 65] * sc);
            o.z = pk4_fp8(sp[8 * 65] * sc, sp[9 * 65] * sc, sp[10 * 65] * sc, sp[11 * 65] * sc);   o.w = pk4_fp8(sp[12 * 65] * sc, sp[13 * 65] * sc, sp[14 * 65] * sc, sp[15 * 65] * sc);
            *(u32x4*)(T.dst + (size_t)(r0 + n) * T.K + k0 + 16 * kq) = o; } }
    LDS_WAIT(); asm volatile("" ::: "memory");
}
__device__ __forceinline__ void p0_prologue(const Args& a, LAS unsigned char* lds, int wave, int lane, int G) {
    LAS float* scr = (LAS float*)(lds + wave * 16640);
    const int gw = blockIdx.x * NWAVES + wave, NGW = G * NWAVES;
    constexpr int I_ADA = 48 * 32, I_IN = 32 * 160, I_UP = 16 * 32, I_O = 32 * 32, I_EG = 32 * 8, I_ED = 8 * 32, I_R = 32 * 1;
    constexpr int NTR = I_IN + 2 * I_UP + I_O + NEX * (2 * I_EG + I_ED) + I_R;
    int it = gw;
    for (; it < I_ADA; it += NGW) p0_ada_item(a, (float*)(a.ws + WS_PART), scr, it, lane);
    it -= I_ADA;
    if (it >= NTR) return;
    f32x4 tvC[16], tvN[16];
    P0Item TC = p0_decode(a, it), TN = TC;
    P0_LOAD(TC, tvC); P0_WAIT(tvC, 0);
    for (;;) {
        const bool hasN = it + NGW < NTR;
        if (hasN) { TN = p0_decode(a, it + NGW); P0_LOAD(TN, tvN); }
        p0_emit(TC, tvC, scr, lane);
        if (!hasN) break;
        P0_WAIT(tvN, 4);
#pragma unroll
        for (int i = 0; i < 16; ++i) tvC[i] = tvN[i];
        TC = TN; it += NGW;
    }
}
__device__ __forceinline__ void p1_mod_reduce(const Args& a, int G) {
    const float* part = (const float*)(a.ws + WS_PART); float* mod = (float*)(a.ws + WS_MOD);
    for (int i = blockIdx.x * 512 + threadIdx.x; i < NB * NMOD; i += G * 512) { const int n = i % NMOD; float s = a.b_ada[n];
#pragma unroll 8
        for (int kc = 0; kc < 32; ++kc) s += __builtin_nontemporal_load(part + (size_t)kc * NB * NMOD + i);
        mod[i] = s; }
}
template <bool W8, bool XBF, bool WB = true> __device__ __forceinline__ void norm_rows2_mod_bf16(const float* x0, const float* x1, const float* g, const float* sc, const float* sh, bf16_t* o0, bf16_t* o1, int lane, unsigned char* p0 = nullptr, unsigned char* p1 = nullptr) {
    const f32x4* xr0 = (const f32x4*)x0 + lane; const f32x4* xr1 = (const f32x4*)x1 + lane;
    f32x4 v0[8], v1[8]; float s0 = 0.f, s1 = 0.f;
    if (XBF) { const u32x2* b0 = (const u32x2*)x0 + lane; const u32x2* b1 = (const u32x2*)x1 + lane;
#pragma unroll
        for (int j = 0; j < 8; ++j) { const u32x2 a = b0[64 * j], c = b1[64 * j]; v0[j] = (f32x4){bf_lo(a.x), bf_hi(a.x), bf_lo(a.y), bf_hi(a.y)}; v1[j] = (f32x4){bf_lo(c.x), bf_hi(c.x), bf_lo(c.y), bf_hi(c.y)}; } }
    else {
#pragma unroll
        for (int j = 0; j < 8; ++j) { v0[j] = __builtin_nontemporal_load(xr0 + 64 * j); v1[j] = __builtin_nontemporal_load(xr1 + 64 * j); } }
#pragma unroll
    for (int j = 0; j < 8; ++j) { s0 += (v0[j].x * v0[j].x + v0[j].y * v0[j].y) + (v0[j].z * v0[j].z + v0[j].w * v0[j].w); s1 += (v1[j].x * v1[j].x + v1[j].y * v1[j].y) + (v1[j].z * v1[j].z + v1[j].w * v1[j].w); }
#pragma unroll
    for (int o = 1; o < 64; o <<= 1) { s0 += __shfl_xor(s0, o); s1 += __shfl_xor(s1, o); }
    const float r0 = 1.0f / sqrtf(s0 * (1.0f / DM) + 1e-6f), r1 = 1.0f / sqrtf(s1 * (1.0f / DM) + 1e-6f);
    u32x2* q0 = (u32x2*)o0 + lane; u32x2* q1 = (u32x2*)o1 + lane;
    f32x4 mm[8], hv[8];
#pragma unroll
    for (int j = 0; j < 8; ++j) { const f32x4 gg = ((const f32x4*)g)[lane + 64 * j], ss = ((const f32x4*)sc)[lane + 64 * j]; hv[j] = ((const f32x4*)sh)[lane + 64 * j]; mm[j] = gg * (ss + 1.0f); }
#pragma unroll
    for (int j = 0; j < 8; ++j) { const f32x4 m = mm[j], hh = hv[j];
        const f32x4 y0 = v0[j] * r0 * m + hh, y1 = v1[j] * r1 * m + hh;
        if (WB) { u32x2 w; w.x = cvt_pk_bf16(y0.x, y0.y); w.y = cvt_pk_bf16(y0.z, y0.w); q0[64 * j] = w;
            w.x = cvt_pk_bf16(y1.x, y1.y); w.y = cvt_pk_bf16(y1.z, y1.w); q1[64 * j] = w; }
        if (W8) { ((unsigned*)p0)[lane + 64 * j] = pk4_fp8(y0.x, y0.y, y0.z, y0.w); ((unsigned*)p1)[lane + 64 * j] = pk4_fp8(y1.x, y1.y, y1.z, y1.w); } }
}

namespace att {
constexpr float ATT_THR = 8.0f;
constexpr int KV_STAGE = 32768;
__device__ __forceinline__ unsigned off_b(unsigned row, unsigned ch) { return 256u * row + 16u * (ch ^ (((row & 3u) << 2) | ((row >> 2) & 3u))); }
__device__ __forceinline__ float half_swap_max(float m) { auto rr = __builtin_amdgcn_permlane32_swap(__float_as_uint(m), __float_as_uint(m), false, false); return fmaxf(__uint_as_float(rr[0]), __uint_as_float(rr[1])); }
__device__ __forceinline__ float half_swap_sum(float m) { auto rr = __builtin_amdgcn_permlane32_swap(__float_as_uint(m), __float_as_uint(m), false, false); return __uint_as_float(rr[0]) + __uint_as_float(rr[1]); }
__device__ __forceinline__ s16x4 vtr(const LAS unsigned char* p) { typedef short v4i16_t __attribute__((ext_vector_type(4))); return __builtin_bit_cast(s16x4, __builtin_amdgcn_ds_read_tr16_b64_v4i16((LAS v4i16_t*)p)); }
__device__ __forceinline__ bf16x8 pack8(const f32x16& p, int b) {
    u32x4 w; w.x = cvt_pk_bf16(p[b], p[b + 1]); w.y = cvt_pk_bf16(p[b + 2], p[b + 3]); w.z = cvt_pk_bf16(p[b + 4], p[b + 5]); w.w = cvt_pk_bf16(p[b + 6], p[b + 7]); return __builtin_bit_cast(bf16x8, w);
}

template <int DQK, bool DIFF, bool OUT8 = false>
__device__ __forceinline__ void attn_unit(LAS unsigned char* lds, const LAS float* tab, const int lo, bf16_t* proj, const int b, const int colK, const int colV, const int colQ, const int kch0,
                                          const int q0s, const int t0, const int t1, const int a0, const int a1, bf16_t* outp, const int ldo, const int colO, const float lam) {
    constexpr int NS = DQK / 16;
    const int tid = threadIdx.x, lane = tid & 63, wid = __builtin_amdgcn_readfirstlane(tid >> 6), r32 = lane & 31, hi = lane >> 5;
    const size_t rowb = (size_t)b * SEQ;
    bf16x8 qf[NS];
    { const bf16_t* qp = proj + (rowb + q0s + r32) * NPROJ + colQ + hi * 8;
#pragma unroll
      for (int s = 0; s < NS; ++s) qf[s] = *(const bf16x8*)(qp + s * 16); }
    unsigned kaddr[NS];
    { const unsigned xv = ((r32 & 3u) << 2) | ((r32 >> 2) & 3u);
#pragma unroll
      for (int s = 0; s < NS; ++s) kaddr[s] = 256u * r32 + 16u * (((unsigned)(kch0 + 2 * s + hi)) ^ xv); }
    unsigned vaddr[2][4];
    { const unsigned q = (lane & 15) >> 2, p = lane & 3, blk = (lane >> 4) & 1;
#pragma unroll
      for (int t2 = 0; t2 < 2; ++t2)
#pragma unroll
          for (int c = 0; c < 4; ++c) vaddr[t2][c] = 256u * (4u * hi + q) + 16u * ((((unsigned)c ^ q) << 2) | ((2u * blk + (p >> 1)) ^ ((2u * t2 + hi) & 3u))) + 8u * (p & 1u); }
    float m = 0.f, l = 0.f; bool first = true;
    f32x16 o[4];
#pragma unroll
    for (int c = 0; c < 4; ++c)
#pragma unroll
        for (int r = 0; r < 16; ++r) o[c][r] = 0.f;
    const int lr = tid >> 3, lc = (tid & 7) * 2;
    const bf16_t* kg = proj + (rowb + lr) * NPROJ + colK + lc * 8;
    const bf16_t* vg = proj + (rowb + lr) * NPROJ + colV + lc * 8;
    const unsigned wo0 = (unsigned)(lr >> 5) * 8192u + off_b(lr & 31, lc), wo1 = (unsigned)(lr >> 5) * 8192u + off_b(lr & 31, lc + 1);
    u32x4 rk0, rk1, rv0, rv1;
#define ATT_LOAD(t) do { const size_t o_ = (size_t)(t) * 64 * NPROJ; rk0 = *(const u32x4*)(kg + o_); rk1 = *(const u32x4*)(kg + o_ + 8); rv0 = *(const u32x4*)(vg + o_); rv1 = *(const u32x4*)(vg + o_ + 8); } while (0)
#define ATT_STORE(st) do { LAS unsigned char* d_ = lds + (st) * KV_STAGE; *(LAS u32x4*)(d_ + wo0) = rk0; *(LAS u32x4*)(d_ + wo1) = rk1; *(LAS u32x4*)(d_ + 16384 + wo0) = rv0; *(LAS u32x4*)(d_ + 16384 + wo1) = rv1; } while (0)
    ATT_LOAD(t0); ATT_STORE(0);
    __syncthreads();
    int st = 0;
    for (int t = t0; t < t1; ++t) {
        const int stn = (st == 2) ? 0 : st + 1;
        if (t + 1 < t1) ATT_LOAD(t + 1);
        if (t >= a0 && t < a1) {
            const LAS unsigned char* Kb = lds + st * KV_STAGE; const LAS unsigned char* Vb = Kb + 16384;
            f32x16 s0, s1;
            if (t * 64 + 63 - q0s <= lo) { const float cb = tab[0] - m;
#pragma unroll
                for (int r = 0; r < 16; ++r) { s0[r] = cb; s1[r] = cb; } }
            else if (t * 64 - (q0s + 31) - lo >= 0) {
                const LAS float* tb = tab + (t * 64 - (q0s + r32) - lo + 4 * hi);
#pragma unroll
                for (int r = 0; r < 16; ++r) { const int cr = (r & 3) + 8 * (r >> 2); s0[r] = tb[cr] - m; s1[r] = tb[32 + cr] - m; } }
            else { const int base = t * 64 - (q0s + r32) - lo + 4 * hi;
#pragma unroll
                for (int r = 0; r < 16; ++r) { const int cr = (r & 3) + 8 * (r >> 2); const int i0 = base + cr, i1 = base + 32 + cr; s0[r] = tab[i0 > 0 ? i0 : 0] - m; s1[r] = tab[i1 > 0 ? i1 : 0] - m; } }
#pragma unroll
            for (int s = 0; s < NS; ++s) { const bf16x8 k0 = *(const LAS bf16x8*)(Kb + kaddr[s]), k1 = *(const LAS bf16x8*)(Kb + 8192 + kaddr[s]);
                s0 = __builtin_amdgcn_mfma_f32_32x32x16_bf16(k0, qf[s], s0, 0, 0, 0); s1 = __builtin_amdgcn_mfma_f32_32x32x16_bf16(k1, qf[s], s1, 0, 0, 0); }
#define ATT_MX3(a_, b_, c_) __builtin_fmaxf(__builtin_fmaxf((a_), (b_)), (c_))
            float mxa = ATT_MX3(s0[0], s0[1], s1[0]), mxb = ATT_MX3(s0[2], s0[3], s1[1]); mxa = ATT_MX3(mxa, s1[2], s1[3]);
#pragma unroll
            for (int r = 4; r < 16; r += 4) { mxa = ATT_MX3(mxa, s0[r], s0[r + 1]); mxb = ATT_MX3(mxb, s0[r + 2], s0[r + 3]); mxa = ATT_MX3(mxa, s1[r], s1[r + 1]); mxb = ATT_MX3(mxb, s1[r + 2], s1[r + 3]); }
#undef ATT_MX3
            const float mx = half_swap_max(fmaxf(mxa, mxb));
            if (first || __any(mx > ATT_THR)) {
                const float dl = first ? mx : fmaxf(mx, 0.f), f = first ? 1.0f : __builtin_amdgcn_exp2f(-dl);
                m += dl; l *= f; first = false;
#pragma unroll
                for (int r = 0; r < 16; ++r) { s0[r] -= dl; s1[r] -= dl; }
#pragma unroll
                for (int c = 0; c < 4; ++c)
#pragma unroll
                    for (int r = 0; r < 16; ++r) o[c][r] *= f; }
            float rs = 0.f;
#pragma unroll
            for (int r = 0; r < 16; ++r) { s0[r] = __builtin_amdgcn_exp2f(s0[r]); s1[r] = __builtin_amdgcn_exp2f(s1[r]); rs += s0[r] + s1[r]; }
            l += rs;
            const bf16x8 pa00 = pack8(s0, 0), pa01 = pack8(s0, 8), pa10 = pack8(s1, 0), pa11 = pack8(s1, 8);
#pragma unroll
            for (int kh = 0; kh < 2; ++kh)
#pragma unroll
                for (int s2 = 0; s2 < 2; ++s2) { const bf16x8 pa = kh == 0 ? (s2 == 0 ? pa00 : pa01) : (s2 == 0 ? pa10 : pa11);
#pragma unroll
                    for (int c = 0; c < 4; ++c) { const s16x4 v0 = vtr(Vb + kh * 8192 + 256 * (16 * s2) + vaddr[0][c]), v1 = vtr(Vb + kh * 8192 + 256 * (16 * s2 + 8) + vaddr[1][c]);
                        const bf16x8 vf = (bf16x8){v0[0], v0[1], v0[2], v0[3], v1[0], v1[1], v1[2], v1[3]};
                        o[c] = __builtin_amdgcn_mfma_f32_32x32x16_bf16(vf, pa, o[c], 0, 0, 0); } }
        }
        if (t + 1 < t1) ATT_STORE(stn);
        __syncthreads();
        st = stn;
    }
#undef ATT_LOAD
#undef ATT_STORE
    const float inv = 1.0f / half_swap_sum(l);
    bf16_t* orow = outp + (rowb + q0s + r32) * (size_t)ldo + colO + 4 * hi;
    if constexpr (DIFF) {
        LAS float* xch = (LAS float*)lds + (size_t)(wid >> 1) * 4096 + lane;
        if (wid & 1) {
#pragma unroll
            for (int c = 0; c < 4; ++c)
#pragma unroll
                for (int r = 0; r < 16; ++r) xch[(c * 16 + r) * 64] = o[c][r] * inv; }
        __syncthreads();
        if (!(wid & 1)) { float ss = 0.f;
#pragma unroll
            for (int c = 0; c < 4; ++c)
#pragma unroll
                for (int r = 0; r < 16; ++r) { const float d = o[c][r] * inv - lam * xch[(c * 16 + r) * 64]; o[c][r] = d; ss += d * d; }
            ss = half_swap_sum(ss);
            const float rn = (1.0f - LAM_INIT) / sqrtf(ss * (1.0f / 128.0f) + 1e-5f);
#pragma unroll
            for (int c = 0; c < 4; ++c)
#pragma unroll
                for (int g = 0; g < 4; ++g) {
                    if constexpr (OUT8) { unsigned char* orow8 = (unsigned char*)outp + (rowb + q0s + r32) * (size_t)ldo + colO + 4 * hi; const float r8 = rn * YA_SCALE;
                        *(unsigned*)(orow8 + 32 * c + 8 * g) = pk4_fp8(o[c][4 * g] * r8, o[c][4 * g + 1] * r8, o[c][4 * g + 2] * r8, o[c][4 * g + 3] * r8); }
                    else { u32x2 w; w.x = cvt_pk_bf16(o[c][4 * g] * rn, o[c][4 * g + 1] * rn); w.y = cvt_pk_bf16(o[c][4 * g + 2] * rn, o[c][4 * g + 3] * rn); *(u32x2*)(orow + 32 * c + 8 * g) = w; } } }
        __syncthreads();
    } else if constexpr (OUT8) {
        unsigned char* orow8 = (unsigned char*)outp + (rowb + q0s + r32) * (size_t)ldo + colO + 4 * hi; const float sc8 = inv * YB_SCALE;
#pragma unroll
        for (int c = 0; c < 4; ++c)
#pragma unroll
            for (int g = 0; g < 4; ++g) *(unsigned*)(orow8 + 32 * c + 8 * g) = pk4_fp8(o[c][4 * g] * sc8, o[c][4 * g + 1] * sc8, o[c][4 * g + 2] * sc8, o[c][4 * g + 3] * sc8);
    } else {
#pragma unroll
        for (int c = 0; c < 4; ++c)
#pragma unroll
            for (int g = 0; g < 4; ++g) { u32x2 w; w.x = cvt_pk_bf16(o[c][4 * g] * inv, o[c][4 * g + 1] * inv); w.y = cvt_pk_bf16(o[c][4 * g + 2] * inv, o[c][4 * g + 3] * inv); *(u32x2*)(orow + 32 * c + 8 * g) = w; }
    }
}
__device__ __forceinline__ int t5_bucket(int rel) {
    const int n = rel < 0 ? -rel : rel;
    const int large = 8 + (n >= 12) + (n >= 16) + (n >= 23) + (n >= 32) + (n >= 46) + (n >= 64) + (n >= 91);
    return (rel > 0 ? 16 : 0) + (n < 8 ? n : large);
}
}

__device__ __forceinline__ void p4_attention(const Args& a, LAS unsigned char* lds, int G, bf16_t* outA, bf16_t* outB, int ldo, int colOA, int colOB) {
    bf16_t* proj = (bf16_t*)(a.ws + WS_PROJ);
    LAS float* tab = (LAS float*)(lds + TAB_OFF);
    const int tid = threadIdx.x, wid = __builtin_amdgcn_readfirstlane(tid >> 6);
    float lam;
    { float s01 = 0.f, s23 = 0.f;
      for (int i = 0; i < 64; ++i) { s01 += a.lambda_qk[i] * a.lambda_qk[64 + i]; s23 += a.lambda_qk[128 + i] * a.lambda_qk[192 + i]; }
      lam = expf(s01) - expf(s23) + LAM_INIT; }
    for (int it = blockIdx.x; it < NB * 8 * 8; it += G) {
        const int bh = it >> 3, j = it & 7, b = bh >> 3, h = bh & 7;
        __syncthreads();
        if (tid < 155) tab[tid] = a.t5_bias[att::t5_bucket(tid - 91) * 8 + h] * LOG2E;
        for (int half = 0; half < 2; ++half) {
            const int p = half ? 15 - j : j;
            const int map = wid & 1, qsub = wid >> 1, qc = 2 * p + (qsub >> 1);
            __syncthreads();
            att::attn_unit<64, true, true>(lds, tab, -91, proj, b, C_KA + h * 128, C_VA + h * 128, C_QA + h * 128 + map * 64, map * 8, 128 * p + 32 * qsub, 0, 2 * p + 2, 0, qc + 1, (bf16_t*)(a.ws + WS_YA8), 1024, h * 128, lam);
        }
    }
    for (int it = blockIdx.x; it < NB * 8 * 8; it += G) {
        const int bh = it >> 3, g = it & 7, b = bh >> 3, h = bh & 7;
        __syncthreads();
        if (tid < 320) { tab[tid] = a.rel_bias[(size_t)(tid  ) * 8 + h] * LOG2E; }
        const int n = 4 * g + (wid >> 1);
        const int t0 = 4 * g - 8 > 0 ? 4 * g - 8 : 0, a0 = n - 8 > 0 ? n - 8 : 0;
        __syncthreads();
        att::attn_unit<128, false, true>(lds, tab, -256, proj, b, C_KB + h * 128, C_VB + h * 128, C_QB + h * 128, 0, 64 * n + 32 * (wid & 1), t0, 4 * g + 4, a0, n + 1, (bf16_t*)(a.ws + WS_YB8), 1024, h * 128, 0.f);
    }
}

template <int CTRL> __device__ __forceinline__ float p7_dpp(float v) { return __int_as_float(__builtin_amdgcn_update_dpp(0, __float_as_int(v), CTRL, 0xf, 0xf, false)); }
__device__ __forceinline__ float p7_grp8_max(float v) {
    v = fmaxf(v, p7_dpp<0xB1>(v)); v = fmaxf(v, p7_dpp<0x4E>(v)); v = fmaxf(v, p7_dpp<0x141>(v)); return v; }
__device__ __forceinline__ float p7_wave_max(float v) {
    v = p7_grp8_max(v); v = fmaxf(v, p7_dpp<0x140>(v));
    const float r0 = __int_as_float(__builtin_amdgcn_readlane(__float_as_int(v), 0)), r1 = __int_as_float(__builtin_amdgcn_readlane(__float_as_int(v), 16));
    const float r2 = __int_as_float(__builtin_amdgcn_readlane(__float_as_int(v), 32)), r3 = __int_as_float(__builtin_amdgcn_readlane(__float_as_int(v), 48));
    return fmaxf(fmaxf(r0, r1), fmaxf(r2, r3)); }
__device__ __forceinline__ void p7_norm_route(const Args& a, LAS unsigned char* lds, int G) {
    const int tid = threadIdx.x, lane = tid & 63, wid = __builtin_amdgcn_readfirstlane(tid >> 6);
    const float* mod = (const float*)(a.ws + WS_MOD);
    bf16_t* V = (bf16_t*)(a.ws + WS_UV); const bf16_t* WrT = (const bf16_t*)(a.ws + WS_WRT);
    unsigned* ctl = (unsigned*)(a.ws + WS_CTL);
    int* selpk = (int*)(a.ws + WS_SELPK); float* selw = (float*)(a.ws + WS_SELW); int* tokof = (int*)(a.ws + WS_TOK);
    LAS float* S1 = (LAS float*)lds; LAS float* S2 = (LAS float*)(lds + 16640); LAS unsigned* lcnt = (LAS unsigned*)(lds + 33280); LAS unsigned* gbase = (LAS unsigned*)(lds + 33536);
    for (int blk = blockIdx.x; blk < T / 64; blk += G) {
        const int r0 = blk * 64, b = r0 >> 11;
        __syncthreads();
        if (tid < 64) lcnt[tid] = 0u;
        {
            const bf16_t* hb = (const bf16_t*)(a.ws + WS_H1) + (size_t)(r0 + 8 * wid) * DM;
            const float* gq = a.g_moe; const float* scq = mod + (size_t)b * NMOD + 4 * DM; const float* shq = mod + (size_t)b * NMOD + 3 * DM;
            u32x2 cur[2][8], nxt[2][8];
#pragma unroll
            for (int r = 0; r < 2; ++r)
#pragma unroll
                for (int j = 0; j < 8; ++j) cur[r][j] = ((const u32x2*)(hb + (size_t)r * DM) + lane)[64 * j];
            f32x4 mm[8], hv[8];
#pragma unroll
            for (int j = 0; j < 8; ++j) { const f32x4 gg = ((const f32x4*)gq)[lane + 64 * j], ss = ((const f32x4*)scq)[lane + 64 * j]; hv[j] = ((const f32x4*)shq)[lane + 64 * j]; mm[j] = gg * (ss + 1.0f); }
#pragma unroll
            for (int i = 0; i < 8; i += 2) {
                if (i + 2 < 8) {
#pragma unroll
                    for (int r = 0; r < 2; ++r)
#pragma unroll
                        for (int j = 0; j < 8; ++j) nxt[r][j] = ((const u32x2*)(hb + (size_t)(i + 2 + r) * DM) + lane)[64 * j]; }
                __builtin_amdgcn_sched_barrier(0);
                float s0 = 0.f, s1 = 0.f;
#pragma unroll
                for (int j = 0; j < 8; ++j) { const float a0 = bf_lo(cur[0][j].x), a1 = bf_hi(cur[0][j].x), a2 = bf_lo(cur[0][j].y), a3 = bf_hi(cur[0][j].y); s0 += (a0 * a0 + a1 * a1) + (a2 * a2 + a3 * a3);
                    const float c0 = bf_lo(cur[1][j].x), c1 = bf_hi(cur[1][j].x), c2 = bf_lo(cur[1][j].y), c3 = bf_hi(cur[1][j].y); s1 += (c0 * c0 + c1 * c1) + (c2 * c2 + c3 * c3); }
#pragma unroll
                for (int o = 1; o < 64; o <<= 1) { s0 += __shfl_xor(s0, o); s1 += __shfl_xor(s1, o); }
                const float rn0 = 1.0f / sqrtf(s0 * (1.0f / DM) + 1e-6f), rn1 = 1.0f / sqrtf(s1 * (1.0f / DM) + 1e-6f);
                const int row = r0 + 8 * wid + i;
                u32x2* q0 = (u32x2*)(V + (size_t)row * DM) + lane; u32x2* q1 = (u32x2*)(V + (size_t)(row + 1) * DM) + lane;
                unsigned* p0 = (unsigned*)(a.ws + WS_V8 + (size_t)row * DM) + lane; unsigned* p1 = (unsigned*)(a.ws + WS_V8 + (size_t)(row + 1) * DM) + lane;
#pragma unroll
                for (int j = 0; j < 8; ++j) { const f32x4 x0 = (f32x4){bf_lo(cur[0][j].x), bf_hi(cur[0][j].x), bf_lo(cur[0][j].y), bf_hi(cur[0][j].y)}, x1 = (f32x4){bf_lo(cur[1][j].x), bf_hi(cur[1][j].x), bf_lo(cur[1][j].y), bf_hi(cur[1][j].y)};
                    const f32x4 y0 = x0 * rn0 * mm[j] + hv[j], y1 = x1 * rn1 * mm[j] + hv[j];
                    u32x2 w; w.x = cvt_pk_bf16(y0.x, y0.y); w.y = cvt_pk_bf16(y0.z, y0.w); q0[64 * j] = w; w.x = cvt_pk_bf16(y1.x, y1.y); w.y = cvt_pk_bf16(y1.z, y1.w); q1[64 * j] = w;
                    p0[64 * j] = pk4_fp8(y0.x, y0.y, y0.z, y0.w); p1[64 * j] = pk4_fp8(y1.x, y1.y, y1.z, y1.w); }
                if (i + 2 < 8) {
#pragma unroll
                    for (int r = 0; r < 2; ++r)
#pragma unroll
                        for (int j = 0; j < 8; ++j) cur[r][j] = nxt[r][j]; }
            }
        }
        VM_WAIT(); __syncthreads();
        {
            constexpr int RP = 528; unsigned stg_ = 34816u; asm volatile("" : "+s"(stg_));
            LAS unsigned char* LA = lds + stg_; LAS unsigned char* LB = LA + 64 * RP;
            int t2_ = threadIdx.x; asm volatile("" : "+v"(t2_));
            const int lane = t2_ & 63, wid = __builtin_amdgcn_readfirstlane(t2_ >> 6);
            const int rb = wid & 3, eh = wid >> 2, half = lane >> 5, c16 = lane & 31;
            f32x4 acc0 = (f32x4){0.f, 0.f, 0.f, 0.f}, acc1 = acc0;
            const bf16_t* gA = V + (size_t)(r0 + 8 * wid + half) * DM + 8 * c16; const bf16_t* gB = WrT + (size_t)(8 * wid + half) * DM + 8 * c16;
            const unsigned wofs = (unsigned)(8 * wid + half) * RP + 16u * c16;
            const unsigned fa = (unsigned)(16 * rb + (lane & 15)) * RP + 16u * (lane >> 4), fb = (unsigned)(32 * eh + (lane & 15)) * RP + 16u * (lane >> 4);
            u32x4 pa[4], pb[4];
#pragma unroll
            for (int i = 0; i < 4; ++i) { pa[i] = *(const u32x4*)(gA + (size_t)(2 * i) * DM); pb[i] = *(const u32x4*)(gB + (size_t)(2 * i) * DM); }
#pragma unroll 1
            for (int c = 0; c < 8; ++c) {
#pragma unroll
                for (int i = 0; i < 4; ++i) { *(LAS u32x4*)(LA + wofs + 2 * i * RP) = pa[i]; *(LAS u32x4*)(LB + wofs + 2 * i * RP) = pb[i]; }
                __syncthreads();
                if (c + 1 < 8) {
#pragma unroll
                    for (int i = 0; i < 4; ++i) { pa[i] = *(const u32x4*)(gA + (size_t)(2 * i) * DM + 256 * (c + 1)); pb[i] = *(const u32x4*)(gB + (size_t)(2 * i) * DM + 256 * (c + 1)); } }
#pragma unroll
                for (int kk = 0; kk < 8; ++kk) { const bf16x8 av = *(const LAS bf16x8*)(LA + fa + 64 * kk), b0 = *(const LAS bf16x8*)(LB + fb + 64 * kk), b1 = *(const LAS bf16x8*)(LB + fb + 16 * RP + 64 * kk);
                    acc0 = __builtin_amdgcn_mfma_f32_16x16x32_bf16(av, b0, acc0, 0, 0, 0); acc1 = __builtin_amdgcn_mfma_f32_16x16x32_bf16(av, b1, acc1, 0, 0, 0); }
                __syncthreads();
            }
#pragma unroll
            for (int r = 0; r < 4; ++r) { const int row = 16 * rb + 4 * (lane >> 4) + r; S1[row * 65 + 32 * eh + (lane & 15)] = acc0[r]; S1[row * 65 + 32 * eh + 16 + (lane & 15)] = acc1[r]; }
        }
        __syncthreads();
        LAS int* selE = (LAS int*)S2; LAS float* selW = (LAS float*)S2 + 512; LAS int* selR = (LAS int*)S2 + 1024;
        {
            const float rb = a.router_bias[lane];
            for (int i = 0; i < 8; ++i) { const int t = 8 * wid + i;
                const float sg = 1.0f / (1.0f + expf(-S1[t * 65 + lane])); const float bs = sg + rb;
                const float m1 = p7_grp8_max(bs);
                const unsigned long long eq = __ballot(bs == m1);
                const int first = __builtin_ctz(((unsigned)(eq >> (lane & 56)) & 0xffu) | 0x100u);
                const float m2 = p7_grp8_max(((lane & 7) == first) ? -1e30f : bs);
                const float gs = m1 + m2;
                bool chosen = false;
#pragma unroll
                for (int it = 0; it < 4; ++it) { const float c = chosen ? -1e30f : gs; const float b = p7_wave_max(c); const unsigned long long mm = __ballot(c == b);
                    const int gl = __builtin_amdgcn_readfirstlane((int)(__builtin_ctzll(mm | (1ull << 63)) >> 3)); chosen = chosen || ((lane >> 3) == gl); }
                float cand = chosen ? bs : -3e38f, wsum = 0.f, myW = 0.f; int myE = 0;
#pragma unroll
                for (int k = 0; k < 8; ++k) { const float b = p7_wave_max(cand); const unsigned long long mm = __ballot(cand == b);
                    const int pick = __builtin_amdgcn_readfirstlane((int)__builtin_ctzll(mm | (1ull << 63)));
                    const float wk = __int_as_float(__builtin_amdgcn_readlane(__float_as_int(sg), pick));
                    cand = (lane == pick) ? -3e38f : cand; if (lane == k) { myE = pick; myW = wk; } wsum += wk; }
                if (lane < 8) { const int lr = (int)atomicAdd((unsigned*)(lcnt + myE), 1u); selE[t * 8 + lane] = myE; selW[t * 8 + lane] = myW * (2.5f / wsum); selR[t * 8 + lane] = lr; }
            }
        }
        __syncthreads();
        if (tid < 64) { const unsigned c = lcnt[tid]; gbase[tid] = c ? __hip_atomic_fetch_add(ctl + CW_CNT + 64 * tid, c, __ATOMIC_RELAXED, __HIP_MEMORY_SCOPE_AGENT) : 0u; }
        __syncthreads();
        { const int t = tid >> 3, k = tid & 7, e = selE[tid], rank = (int)gbase[e] + selR[tid];
          tokof[(size_t)e * ECAP + rank] = r0 + t; selpk[(size_t)(r0 + t) * 8 + k] = (e << 16) | rank; selw[(size_t)(r0 + t) * 8 + k] = selW[tid]; }
    }
}

struct MoeTab { LAS int* tstart; LAS int* cnt; LAS int* nun; LAS int* ug; LAS int* upn; LAS int* ue; LAS unsigned short* rowtab; };
__device__ __forceinline__ MoeTab moe_tab(LAS unsigned char* lds) { LAS unsigned char* p = lds + TAB_OFF; MoeTab m; m.tstart = (LAS int*)p; m.cnt = (LAS int*)(p + 272); m.nun = (LAS int*)(p + 540); m.ug = (LAS int*)(p + 544); m.upn = (LAS int*)(p + 640); m.ue = (LAS int*)(p + 736); m.rowtab = (LAS unsigned short*)(p + 1024); return m; }
__device__ __forceinline__ void moe_build_tstart(const Args& a, const MoeTab& m, const int tidx) {
    const int tid = tidx; unsigned* ctl = (unsigned*)(a.ws + WS_CTL);
    __syncthreads();
    if (tid < 64) { const int c = (int)__hip_atomic_load(ctl + CW_CNT + 64 * tid, __ATOMIC_RELAXED, __HIP_MEMORY_SCOPE_AGENT); m.cnt[tid] = c;
        const int tiles = (c + 255) >> 8; int inc = tiles;
#pragma unroll
        for (int o = 1; o < 64; o <<= 1) { const int v = __shfl_up(inc, o); inc += (tid >= o) ? v : 0; }
        m.tstart[tid] = inc - tiles;
        if (tid == 63) { m.tstart[NE] = inc; m.tstart[NEX] = inc + ((T + 255) >> 8); m.cnt[NE] = T; } }
    __syncthreads();
}
template <int NPN> __device__ __forceinline__ void moe_build_units(const MoeTab& m, int G, const int tidx) {
    const int tid = tidx;
    if (tid < 24) { const int nwg = m.tstart[NEX] * NPN; const long L = (long)tid * G + blockIdx.x; int g = -1, pn = 0, e = 0;
        if (L < nwg) { int wgid = (int)L; { const int q = nwg / 8, r = nwg % 8, xcd = wgid % 8, off = wgid / 8; wgid = (xcd < r ? xcd * (q + 1) : r * (q + 1) + (xcd - r) * q) + off; }
            g = wgid / NPN; pn = wgid % NPN; for (int k = 1; k < NEX; ++k) e += (m.tstart[k] <= g) ? 1 : 0; }
        m.ug[tid] = g; m.upn[tid] = pn; m.ue[tid] = e; }
    __syncthreads();
    if (tid == 0) { int n = 0; while (n < 24 && m.ug[n] >= 0) ++n; m.nun[0] = n; }
    __syncthreads();
}
struct MoeOrder8 {
    static constexpr bool GATHER = true;
    MoeTab m; const char* A; const char* B; int nun;
    __device__ __forceinline__ bool next(int i, pg8::Unit& u) const { if (i >= nun) return false; u.pm = m.ug[i]; u.pn = m.upn[i]; u.A = A; u.B = B + ((size_t)m.ue[i] * 1024 + (size_t)u.pn * 256) * DM; u.slot = i; return true; }
    __device__ __forceinline__ unsigned row(const pg8::Unit& u, int r) const { return (unsigned)m.rowtab[u.slot * 256 + r]; }
};
struct MoeOrder9 {
    static constexpr bool GATHER = true;
    MoeTab m; const char* A; const char* B; int nun;
    __device__ __forceinline__ bool next(int i, pg8::Unit& u) const { if (i >= nun) return false; u.pm = m.ug[i]; u.pn = m.upn[i]; u.A = A; u.B = B + ((size_t)m.ue[i] * DM + (size_t)u.pn * 256) * DE; u.slot = i; return true; }
    __device__ __forceinline__ unsigned row(const pg8::Unit& u, int r) const { return (unsigned)(u.pm * 256 + r); }
};

__device__ __forceinline__ void p10_combine(const Args& a, LAS unsigned char* lds, int wave, int lane, int G) {
    const MoeTab m = moe_tab(lds);
    moe_build_tstart(a, m, wave * 64 + lane);
    const float* mod = (const float*)(a.ws + WS_MOD); const unsigned char* ys = a.ws + WS_YS;
    const int* selpk = (const int*)(a.ws + WS_SELPK); const float* selw = (const float*)(a.ws + WS_SELW);
    const int gw = blockIdx.x * NWAVES + wave, NGW = G * NWAVES;
    for (int row = 2 * gw; row < T; row += 2 * NGW) {
        const int b = row >> 11;
        size_t pos[2][9]; float w[2][9];
#pragma unroll
        for (int r = 0; r < 2; ++r) {
#pragma unroll
            for (int k = 0; k < 8; ++k) { const int pk = selpk[(size_t)(row + r) * 8 + k]; pos[r][k] = ((size_t)m.tstart[pk >> 16] * 256 + (pk & 0xffff)) * DM; w[r][k] = selw[(size_t)(row + r) * 8 + k]; }
            pos[r][8] = ((size_t)m.tstart[NE] * 256 + row + r) * DM; w[r][8] = 1.0f; }
        float ss[2] = {0.f, 0.f}; f32x4 h2[2][4][2];
        float* hrow = a.out + (size_t)row * DM; const bf16_t* h1row = (const bf16_t*)(a.ws + WS_H1) + (size_t)row * DM; const float* gt = mod + (size_t)b * NMOD + 5 * DM;
#pragma unroll
        for (int j = 0; j < 4; ++j) { const int col = 8 * lane + 512 * j;
            const f32x4 g0 = *(const f32x4*)(gt + col), g1 = *(const f32x4*)(gt + col + 4);
#pragma unroll
            for (int r = 0; r < 2; ++r) { float acc[8];
#pragma unroll
                for (int q = 0; q < 8; ++q) acc[q] = 0.f;
#pragma unroll
                for (int k = 0; k < 9; ++k) { const u32x2 y = __builtin_nontemporal_load((const u32x2*)(ys + pos[r][k] + col));
                    const f32x2 y0 = __builtin_amdgcn_cvt_pk_f32_fp8((int)y.x, false), y1 = __builtin_amdgcn_cvt_pk_f32_fp8((int)y.x, true), y2 = __builtin_amdgcn_cvt_pk_f32_fp8((int)y.y, false), y3 = __builtin_amdgcn_cvt_pk_f32_fp8((int)y.y, true);
                    const float wk = w[r][k];
                    acc[0] += wk * y0.x; acc[1] += wk * y0.y; acc[2] += wk * y1.x; acc[3] += wk * y1.y; acc[4] += wk * y2.x; acc[5] += wk * y2.y; acc[6] += wk * y3.x; acc[7] += wk * y3.y; }
                const u32x4 xb = __builtin_nontemporal_load((const u32x4*)(h1row + (size_t)r * DM + col)); const f32x4 x0 = (f32x4){bf_lo(xb.x), bf_hi(xb.x), bf_lo(xb.y), bf_hi(xb.y)}, x1 = (f32x4){bf_lo(xb.z), bf_hi(xb.z), bf_lo(xb.w), bf_hi(xb.w)};
#pragma unroll
                for (int q = 0; q < 4; ++q) { h2[r][j][0][q] = x0[q] + g0[q] * acc[q]; h2[r][j][1][q] = x1[q] + g1[q] * acc[4 + q]; ss[r] += h2[r][j][0][q] * h2[r][j][0][q] + h2[r][j][1][q] * h2[r][j][1][q]; } }
            __builtin_amdgcn_sched_barrier(0); }
#pragma unroll
        for (int o = 1; o < 64; o <<= 1) { ss[0] += __shfl_xor(ss[0], o); ss[1] += __shfl_xor(ss[1], o); }
        const float rs0 = 1.0f / sqrtf(ss[0] * (1.0f / DM) + 1e-6f), rs1 = 1.0f / sqrtf(ss[1] * (1.0f / DM) + 1e-6f);
#pragma unroll
        for (int j = 0; j < 4; ++j) { const int col = 8 * lane + 512 * j; const f32x4 g0 = *(const f32x4*)(a.g_final + col), g1 = *(const f32x4*)(a.g_final + col + 4);
            *(f32x4*)(hrow + col) = h2[0][j][0] * rs0 * g0; *(f32x4*)(hrow + col + 4) = h2[0][j][1] * rs0 * g1;
            *(f32x4*)(hrow + DM + col) = h2[1][j][0] * rs1 * g0; *(f32x4*)(hrow + DM + col + 4) = h2[1][j][1] * rs1 * g1; }
    }
}

__device__ __forceinline__ void ph2_norm1(const Args& args, int wave, int lane, int G) {
    unsigned char* ws = args.ws; const float* mod = (const float*)(ws + WS_MOD); bf16_t* U = (bf16_t*)(ws + WS_UV);
    const int gw = blockIdx.x * NWAVES + wave, NGW = G * NWAVES;
    for (int m = 2 * gw; m < T; m += 2 * NGW) { const int b = m >> 11; norm_rows2_mod_bf16<true, false, false>(args.x + (size_t)m * DM, args.x + (size_t)(m + 1) * DM, args.g_attn, mod + (size_t)b * NMOD + DM, mod + (size_t)b * NMOD, U + (size_t)m * DM, U + (size_t)(m + 1) * DM, lane, ws + WS_U8 + (size_t)m * DM, ws + WS_U8 + (size_t)(m + 1) * DM); }
}
__device__ __forceinline__ void ph3_proj(const Args& args, LAS unsigned char* lds, int G) {
    unsigned char* ws = args.ws;
    {
      pg8::StaticOrderG S; S.init(T, 6144, G, (int)blockIdx.x, ws + WS_U8, DM / 2, ws + WS_WIN, DM / 2);
      pg8::EpiProjB<false> E{(bf16_t*)(ws + WS_PROJ), 1.0f / WINB_SCALE};
      pg8::gemm_phase<pg8::EpiProjB<false>, pg8::StaticOrderG, true, true>(lds, DM / 2, DM / 2, DM / 2, S, E, (int)threadIdx.x); }
    __syncthreads();
    {
      pg8::StaticOrderG S; S.init(T, 4096, G, (int)blockIdx.x, ws + WS_U8, DM / 2, ws + WS_WIN + (size_t)6144 * DM, DM / 2);
      pg8::EpiProjB<true> E{(bf16_t*)(ws + WS_PROJ), 1.0f / WINB_SCALE};
      pg8::gemm_phase<pg8::EpiProjB<true>, pg8::StaticOrderG, true, true>(lds, DM / 2, DM / 2, DM / 2, S, E, (int)threadIdx.x); }
}
__device__ __forceinline__ void ph5_gates(const Args& args, LAS unsigned char* lds, int G) {
    unsigned char* ws = args.ws;
    const bf16_t* proj = (const bf16_t*)(ws + WS_PROJ);
    static_assert(WUA_SCALE * YA_SCALE == WUB_SCALE * YB_SCALE, "both halves must carry the same operand scale");
    pg8::StaticOrderG S; S.init(T, DM, G, (int)blockIdx.x, ws + WS_YA8, 512, ws + WS_WUA, 512);
    pg8::EpiGate2 E{proj + C_GA, proj + C_GB, NPROJ, DM, 1.0f / (WUA_SCALE * YA_SCALE), ws + WS_M8};
    pg8::gemm_phase<pg8::EpiGate2, pg8::StaticOrderG, true, true>(lds, DM / 2, 512, 512, S, E, (int)threadIdx.x, (long)WS_YB8 - (long)WS_YA8, (long)WS_WUB - (long)WS_WUA);
}
__device__ __forceinline__ void ph6_wo(const Args& args, LAS unsigned char* lds, int G) {
    unsigned char* ws = args.ws;
    pg8::StaticOrderG S; S.init(T, DM, G, (int)blockIdx.x, ws + WS_M8, DM / 2, ws + WS_WO, DM / 2);
    pg8::EpiRes E{args.x, (const float*)(ws + WS_MOD) + 2 * DM, (bf16_t*)(ws + WS_H1), 1.0f / (WO_SCALE * MG_SCALE)};
    pg8::gemm_phase<pg8::EpiRes, pg8::StaticOrderG, true, true>(lds, DM / 2, DM / 2, DM / 2, S, E, (int)threadIdx.x);
}
__device__ __forceinline__ void ph8_gateup(const Args& args, LAS unsigned char* lds, int G, const int tidx) {
    unsigned char* ws = args.ws; const int tid = tidx;
    const MoeTab m = moe_tab(lds);
    moe_build_tstart(args, m, tidx);
    moe_build_units<4>(m, G, tidx);
    { const int* tokof = (const int*)(ws + WS_TOK); const int nun = m.nun[0];
      int tkv[6];
#pragma unroll
      for (int it = 0; it < 6; ++it) { const int q = tid + it * (NWAVES * 64); tkv[it] = 0;
          if (q < nun * 256) { const int i = q >> 8, r = q & 255, e = m.ue[i], idx = (m.ug[i] - m.tstart[e]) * 256 + r;
              tkv[it] = (e == NE) ? idx : (idx < m.cnt[e] ? tokof[(size_t)e * ECAP + idx] : 0); } }
#pragma unroll
      for (int it = 0; it < 6; ++it) { const int q = tid + it * (NWAVES * 64); if (q < nun * 256) m.rowtab[q] = (unsigned short)tkv[it]; }
      for (int q = tid + 6 * (NWAVES * 64); q < nun * 256; q += NWAVES * 64) { const int i = q >> 8, r = q & 255, e = m.ue[i], idx = (m.ug[i] - m.tstart[e]) * 256 + r;
          const int tk = (e == NE) ? idx : (idx < m.cnt[e] ? tokof[(size_t)e * ECAP + idx] : 0); m.rowtab[q] = (unsigned short)tk; } }
    __syncthreads();
    MoeOrder8 S{m, (const char*)(ws + WS_V8), (const char*)(ws + WS_WGU), __builtin_amdgcn_readfirstlane(m.nun[0])};
    pg8::EpiSwiGLU8 E{ws + WS_HB, 1.0f / WGU_SCALE};
    pg8::gemm_phase<pg8::EpiSwiGLU8, MoeOrder8, true, true>(lds, DM / 2, DM / 2, DM / 2, S, E, tidx);
}
__device__ __forceinline__ void ph9_down(const Args& args, LAS unsigned char* lds, int G, const int tidx) {
    unsigned char* ws = args.ws;
    const MoeTab m = moe_tab(lds);
    moe_build_tstart(args, m, tidx);
    moe_build_units<8>(m, G, tidx);
    MoeOrder9 S{m, (const char*)(ws + WS_HB), (const char*)(ws + WS_WD), __builtin_amdgcn_readfirstlane(m.nun[0])};
    pg8::EpiYs8 E{ws + WS_YS, 1.0f / WD_SCALE};
    pg8::gemm_phase<pg8::EpiYs8, MoeOrder9, true, true>(lds, DE / 2, DE / 2, DE / 2, S, E, tidx);
}

constexpr int NPHASES = 11;
typedef const __attribute__((address_space(4))) Args* KArgP;
__device__ __forceinline__ Args load_args() {
#if defined(__HIP_DEVICE_COMPILE__)
    KArgP kp = (KArgP)__builtin_amdgcn_kernarg_segment_ptr();
    asm volatile("" : "+s"(kp));
    const Args* gp = (const Args*)kp;
    return *gp;
#else
    return Args{};
#endif
}
__global__ void __launch_bounds__(NWAVES * 64, 2) mk_fwd(Args args_unused) {
    extern __shared__ __attribute__((aligned(16))) unsigned char lds_raw[];
    LAS unsigned char* lds = (LAS unsigned char*)lds_raw;
    volatile LAS unsigned* MISC = (volatile LAS unsigned*)(lds + MISC_OFF);
    const int G = gridDim.x;
    const int s_wave_ = __builtin_amdgcn_readfirstlane((int)threadIdx.x >> 6);
#define TIDSW() (s_wave_ * 64 + (int)asm_lane_id())
    if (threadIdx.x < 64) MISC[threadIdx.x] = 0u;
#define PH_IDS const int lane = (int)asm_lane_id(), wave = s_wave_
    __syncthreads();
    int lo, hi; unsigned* ctl;
    { const Args a0 = load_args(); lo = a0.ph_lo; hi = a0.ph_hi; ctl = (unsigned*)(a0.ws + WS_CTL); }
    XcdBarrier bar; bar.bar = ctl + CW_BAR; bar.x = 0; bar.st = nullptr;
    if (hi - lo > 1) bar = xcd_barrier_post(ctl + CW_BAR, MISC + 8);
#ifndef PH_MASK
#define PH_MASK 0x7ff
#endif
#define IN(k) (((PH_MASK >> (k)) & 1) && lo <= (k) && (k) < hi)
#define SEAM(k) do { if (IN(k) && IN((k) + 1)) xcd_barrier(bar, TIDSW()); } while (0)

    if (IN(0)) { const Args args = load_args(); PH_IDS; p0_prologue(args, lds, wave, lane, G); } SEAM(0);
    if (IN(1)) { const Args args = load_args(); p1_mod_reduce(args, G); } SEAM(1);
    if (IN(2)) { const Args args = load_args(); PH_IDS; ph2_norm1(args, wave, lane, G); } SEAM(2);
    if (IN(3)) { const Args args = load_args(); ph3_proj(args, lds, G); } SEAM(3);
    if (IN(4)) { const Args args = load_args(); bf16_t* proj = (bf16_t*)(args.ws + WS_PROJ); p4_attention(args, lds, G, proj, proj, NPROJ, C_QA, C_QB); } SEAM(4);
    if (IN(5)) { const Args args = load_args(); ph5_gates(args, lds, G); } SEAM(5);
    if (IN(6)) { const Args args = load_args(); ph6_wo(args, lds, G); } SEAM(6);
    if (IN(7)) { const Args args = load_args(); p7_norm_route(args, lds, G); } SEAM(7);
    if (IN(8)) { const Args args = load_args(); ph8_gateup(args, lds, G, TIDSW()); } SEAM(8);
    if (IN(9)) { const Args args = load_args(); ph9_down(args, lds, G, TIDSW()); } SEAM(9);
    if (IN(10)) { const Args args = load_args(); PH_IDS; p10_combine(args, lds, wave, lane, G); }
#undef IN
#undef SEAM
#undef PH_IDS
}

extern "C" void kernel_launch(void* const* d_in, const int* in_sizes, int n_in, void* d_out, int out_size, void* d_ws, size_t ws_size, hipStream_t stream) {
    static int grid = 0;
    if (grid == 0) {
        if (n_in != 22 || in_sizes[0] != T * DM || out_size != T * DM || ws_size < WS_END) { fprintf(stderr, "kernel_launch: unexpected problem (n_in %d, in0 %d, out %d, ws %zu < %zu)\n", n_in, n_in > 0 ? in_sizes[0] : -1, out_size, ws_size, (size_t)WS_END); grid = -1; return; }
        int dev = 0, cus = 0, per_cu = 0;
        if (hipGetDevice(&dev) != hipSuccess || hipDeviceGetAttribute(&cus, hipDeviceAttributeMultiprocessorCount, dev) != hipSuccess) { grid = -1; return; }
        if (hipFuncSetAttribute((const void*)mk_fwd, hipFuncAttributeMaxDynamicSharedMemorySize, LDS_BYTES) != hipSuccess) { fprintf(stderr, "kernel_launch: hipFuncSetAttribute failed\n"); grid = -1; return; }
        if (hipOccupancyMaxActiveBlocksPerMultiprocessor(&per_cu, (const void*)mk_fwd, NWAVES * 64, LDS_BYTES) != hipSuccess || per_cu < 1) { fprintf(stderr, "kernel_launch: occupancy query reports %d\n", per_cu); }
        (void)hipGetLastError();
        grid = cus;
    }
    if (grid < 0) return;
    if (hipMemsetAsync((char*)d_ws + WS_CTL, 0, CTL_ZERO_BYTES, stream) != hipSuccess) return;
    Args a{};
    a.x = (const float*)d_in[0]; a.c = (const float*)d_in[1]; a.w_ada = (const float*)d_in[2]; a.b_ada = (const float*)d_in[3]; a.g_attn = (const float*)d_in[4]; a.w_in = (const float*)d_in[5];
    a.lambda_qk = (const float*)d_in[6]; a.t5_bias = (const float*)d_in[7]; a.rel_bias = (const float*)d_in[8]; a.w_up_a = (const float*)d_in[9]; a.w_up_b = (const float*)d_in[10]; a.w_o = (const float*)d_in[11];
    a.g_moe = (const float*)d_in[12]; a.w_router = (const float*)d_in[13]; a.router_bias = (const float*)d_in[14]; a.w_exp_gate = (const float*)d_in[15]; a.w_exp_up = (const float*)d_in[16]; a.w_exp_down = (const float*)d_in[17];
    a.w_sh_gate = (const float*)d_in[18]; a.w_sh_up = (const float*)d_in[19]; a.w_sh_down = (const float*)d_in[20]; a.g_final = (const float*)d_in[21];
    a.out = (float*)d_out; a.ws = (unsigned char*)d_ws;
    constexpr int NL = MK_N_LAUNCHES;
    static_assert(NL == 1 || NL == NPHASES, "MK_N_LAUNCHES is 1 or 11");
    for (int li = 0; li < NL; ++li) {
        a.ph_lo = (NL == 1) ? 0 : li; a.ph_hi = (NL == 1) ? NPHASES : li + 1;
        hipLaunchKernelGGL(mk_fwd, dim3(grid), dim3(NWAVES * 64), LDS_BYTES, stream, a);
        const hipError_t le = hipPeekAtLastError();
        if (le != hipSuccess) { fprintf(stderr, "kernel_launch: launch %d failed: %s\n", li, hipGetErrorName(le)); break; }
    }
}
```
